# Optimizing an MI355X kernel written in HIP

```python
import math
import jax
import jax.numpy as jnp
from jax import lax
import numpy as np

D_MODEL = 1024
BATCH = 8
SEQ = 4096
DEPTH = 2

RWKV_HEADS = 8
RWKV_HEAD_DIM = 64
RWKV_DIM = RWKV_HEADS * RWKV_HEAD_DIM
RWKV_W_LORA = 64
RWKV_A_LORA = 64
RWKV_G_LORA = 128
RWKV_GN_EPS = 64e-5
MLA_HEADS = 8
MLA_Q_LORA = 256
MLA_KV_LORA = 128
MLA_NOPE_DIM = 64
MLA_ROPE_DIM = 32
MLA_V_DIM = 64
MLA_DIM = MLA_HEADS * MLA_V_DIM
ROPE_BASE = 10000.0
DIFF_HEADS = 4
DIFF_QK_DIM = 64
DIFF_V_DIM = 2 * DIFF_QK_DIM
DIFF_DIM = DIFF_HEADS * DIFF_V_DIM
REL_BUCKETS = 32
REL_MAX_DISTANCE = 128
D_FF = 2816
CONV_WIDTH = 3
N_BRANCHES = 3
Q_BLOCK = 128
NORM_EPS = 1e-6

RWKV_COLS = 3 * RWKV_DIM + RWKV_W_LORA + RWKV_A_LORA + RWKV_G_LORA
MLA_COLS = MLA_Q_LORA + MLA_KV_LORA + MLA_ROPE_DIM
DIFF_COLS = 2 * (DIFF_HEADS * 2 * DIFF_QK_DIM) + DIFF_DIM
GATE_COLS = N_BRANCHES * D_MODEL
IN_COLS = RWKV_COLS + MLA_COLS + DIFF_COLS + GATE_COLS
IN_SPLITS = (RWKV_COLS, RWKV_COLS + MLA_COLS, RWKV_COLS + MLA_COLS + DIFF_COLS)
RWKV_SPLITS = (RWKV_DIM, 2 * RWKV_DIM, 3 * RWKV_DIM, 3 * RWKV_DIM + RWKV_W_LORA,
               3 * RWKV_DIM + RWKV_W_LORA + RWKV_A_LORA)

kernel_name = 'hybrid_rwkv7_mla_diffattn_convffn'


def _rmsnorm(x, g, eps=NORM_EPS):
    xf = x.astype(jnp.float32)
    y = xf * lax.rsqrt(jnp.mean(xf * xf, axis=-1, keepdims=True) + eps)
    return (y * g.astype(jnp.float32)).astype(x.dtype)


def _token_shift(p):
    return jnp.pad(p, ((0, 0), (1, 0), (0, 0)))[:, :-1]


def _split_heads(t, n_heads):
    return t.reshape(t.shape[0], t.shape[1], n_heads, t.shape[-1] // n_heads)


def _rope_tables(positions, dtype):
    inv_freq = ROPE_BASE ** (-jnp.arange(0, MLA_ROPE_DIM, 2, dtype=jnp.float32) / MLA_ROPE_DIM)
    ang = positions.astype(jnp.float32)[..., None] * inv_freq
    return jnp.cos(ang).astype(dtype), jnp.sin(ang).astype(dtype)


def _apply_rope(x, cos, sin):
    x1, x2 = jnp.split(x, 2, axis=-1)
    return jnp.concatenate([x1 * cos - x2 * sin, x1 * sin + x2 * cos], axis=-1)


def _t5_bucket(dist):
    n = jnp.maximum(dist, 0)
    max_exact = REL_BUCKETS // 2
    nf = jnp.maximum(n, 1).astype(jnp.float32)
    large = max_exact + (jnp.log(nf / max_exact) / math.log(REL_MAX_DISTANCE / max_exact)
                         * (REL_BUCKETS - max_exact)).astype(jnp.int32)
    large = jnp.minimum(large, REL_BUCKETS - 1)
    return jnp.where(n < max_exact, n, large)


def _masked_softmax(logits, mask):
    logits = jnp.where(mask, logits.astype(jnp.float32), jnp.finfo(jnp.float32).min)
    return jax.nn.softmax(logits, axis=-1)


def _causal_blocks(block_fn, seq_len):
    outs = []
    for i in range(seq_len // Q_BLOCK):
        q0, q1 = i * Q_BLOCK, (i + 1) * Q_BLOCK
        mask = jnp.arange(q0, q1)[:, None] >= jnp.arange(q1)[None, :]
        outs.append(block_fn(q0, q1, mask))
    return jnp.concatenate(outs, axis=2)


def _rwkv7_mix(p, mu, w0, w2, a0, a2, g2, k_k, k_a, r_k, ln_w, ln_b):
    B, S, _ = p.shape
    f32 = jnp.float32
    p = p + (_token_shift(p) - p) * mu
    r, k, v, pw, pa, pg = jnp.split(p, RWKV_SPLITS, axis=-1)
    w_log = -jax.nn.softplus(-(w0 + jnp.tanh(pw) @ w2)) - 0.5
    decay = jnp.exp(-jnp.exp(w_log.astype(f32)))
    a = jax.nn.sigmoid(a0 + pa @ a2)
    g = jax.nn.sigmoid(pg) @ g2
    kk = _split_heads(k * k_k, RWKV_HEADS).astype(f32)
    kk = kk / jnp.maximum(jnp.linalg.norm(kk, axis=-1, keepdims=True), 1e-12)
    k = k * (1 + (a - 1) * k_a)
    r_h, k_h, v_h = _split_heads(r, RWKV_HEADS), _split_heads(k, RWKV_HEADS), _split_heads(v, RWKV_HEADS)
    b_h = kk * _split_heads(a, RWKV_HEADS).astype(f32)
    xs = tuple(jnp.moveaxis(t.astype(f32), 1, 0)
               for t in (r_h, _split_heads(decay, RWKV_HEADS), k_h, v_h, kk, b_h))

    def step(state, inp):
        r_t, w_t, k_t, v_t, kk_t, b_t = inp
        sa = jnp.einsum('bhij,bhj->bhi', state, -kk_t)
        state = (state * w_t[:, :, None, :] + sa[..., None] * b_t[:, :, None, :]
                 + v_t[..., None] * k_t[:, :, None, :])
        return state, jnp.einsum('bhij,bhj->bhi', state, r_t)

    state0 = jnp.zeros((B, RWKV_HEADS, RWKV_HEAD_DIM, RWKV_HEAD_DIM), f32)
    _, y = lax.scan(step, state0, xs)
    y = jnp.moveaxis(y, 0, 1)
    mean = jnp.mean(y, axis=-1, keepdims=True)
    var = jnp.mean(jnp.square(y - mean), axis=-1, keepdims=True)
    y = ((y - mean) * lax.rsqrt(var + RWKV_GN_EPS)).reshape(B, S, RWKV_DIM) * ln_w + ln_b
    bonus = (jnp.sum(r_h * k_h * r_k, axis=-1, keepdims=True) * v_h).reshape(B, S, RWKV_DIM)
    y = (y + bonus.astype(f32)) * g.astype(f32)
    return y.astype(p.dtype)


def _mla_mix(p, cos, sin, q_norm, w_uq, kv_norm, w_ukv):
    B, S, _ = p.shape
    c_q, c_kv, k_rope = jnp.split(p, (MLA_Q_LORA, MLA_Q_LORA + MLA_KV_LORA), axis=-1)
    q = (_rmsnorm(c_q, q_norm) @ w_uq).reshape(B, S, MLA_HEADS, MLA_NOPE_DIM + MLA_ROPE_DIM)
    q = q.transpose(0, 2, 1, 3)
    q_nope = q[..., :MLA_NOPE_DIM]
    q_rope = _apply_rope(q[..., MLA_NOPE_DIM:], cos[:, None], sin[:, None])
    kv = (_rmsnorm(c_kv, kv_norm) @ w_ukv).reshape(B, S, MLA_HEADS, MLA_NOPE_DIM + MLA_V_DIM)
    kv = kv.transpose(0, 2, 1, 3)
    k_nope, v = kv[..., :MLA_NOPE_DIM], kv[..., MLA_NOPE_DIM:]
    k_rope = _apply_rope(k_rope, cos, sin)
    scale = (MLA_NOPE_DIM + MLA_ROPE_DIM) ** -0.5

    def block(q0, q1, mask):
        logits = (jnp.einsum('bhqd,bhkd->bhqk', q_nope[:, :, q0:q1], k_nope[:, :, :q1])
                  + jnp.einsum('bhqd,bkd->bhqk', q_rope[:, :, q0:q1], k_rope[:, :q1]))
        probs = _masked_softmax(logits * scale, mask)
        return jnp.einsum('bhqk,bhkd->bhqd', probs.astype(v.dtype), v[:, :, :q1])

    o = _causal_blocks(block, S)
    return o.transpose(0, 2, 1, 3).reshape(B, S, MLA_DIM)


def _diff_mix(p, positions, rel_bias, lam, subln, layer_idx):
    B, S, _ = p.shape
    qk_w = DIFF_HEADS * 2 * DIFF_QK_DIM
    q, k, v = jnp.split(p, (qk_w, 2 * qk_w), axis=-1)
    q = q.reshape(B, S, DIFF_HEADS, 2, DIFF_QK_DIM).transpose(0, 2, 3, 1, 4)
    k = k.reshape(B, S, DIFF_HEADS, 2, DIFF_QK_DIM).transpose(0, 2, 3, 1, 4)
    v = v.reshape(B, S, DIFF_HEADS, DIFF_V_DIM).transpose(0, 2, 1, 3)
    lambda_init = 0.8 - 0.6 * math.exp(-0.3 * layer_idx)
    lam = lam.astype(jnp.float32)
    lam_full = jnp.exp(jnp.sum(lam[0] * lam[1])) - jnp.exp(jnp.sum(lam[2] * lam[3])) + lambda_init
    scale = DIFF_QK_DIM ** -0.5

    def block(q0, q1, mask):
        dist = positions[:, q0:q1, None] - positions[:, None, :q1]
        bias = rel_bias[_t5_bucket(dist)].transpose(0, 3, 1, 2)[:, :, None]
        logits = jnp.einsum('bhmqd,bhmkd->bhmqk', q[:, :, :, q0:q1], k[:, :, :, :q1]) * scale + bias
        probs = _masked_softmax(logits, mask)
        attn = probs[:, :, 0] - lam_full * probs[:, :, 1]
        return jnp.einsum('bhqk,bhkd->bhqd', attn.astype(v.dtype), v[:, :, :q1])

    o = _causal_blocks(block, S)
    o = _rmsnorm(o, subln, eps=1e-5) * (1 - lambda_init)
    return o.transpose(0, 2, 1, 3).reshape(B, S, DIFF_DIM)


def _conv_ffn(h, w_up, conv_w, conv_b, w_down):
    S = h.shape[1]
    u = h @ w_up
    up = jnp.pad(u, ((0, 0), (CONV_WIDTH - 1, 0), (0, 0)))
    u = sum(conv_w[j] * up[:, j:j + S] for j in range(CONV_WIDTH)) + conv_b
    gate, val = jnp.split(u, 2, axis=-1)
    return (jax.nn.silu(gate) * val) @ w_down


def setup_inputs(seed: int = 0) -> dict:
    key = jax.random.key(seed)
    ks = iter(jax.random.split(key, 40))
    f32 = jnp.float32
    L = DEPTH

    def nrm(shape, scale):
        return jax.random.normal(next(ks), shape, f32) * scale

    def gain(shape):
        return 1.0 + nrm(shape, 0.05)

    offset = jax.random.randint(next(ks), (BATCH, 1), 0, 1024, dtype=jnp.int32)
    positions = offset + jnp.arange(SEQ, dtype=jnp.int32)[None, :]
    return {
        'x': nrm((BATCH, SEQ, D_MODEL), 1.0),
        'positions': positions,
        'rel_bias': nrm((REL_BUCKETS, DIFF_HEADS), 0.5),
        'norm_mix': gain((L, D_MODEL)),
        'w_in': nrm((L, D_MODEL, IN_COLS), D_MODEL ** -0.5),
        'b_gate': nrm((L, GATE_COLS), 0.1),
        'rwkv_mu': jax.random.uniform(next(ks), (L, RWKV_COLS), f32),
        'rwkv_w0': jax.random.uniform(next(ks), (L, RWKV_DIM), f32, minval=-6.0, maxval=-1.0),
        'rwkv_w2': nrm((L, RWKV_W_LORA, RWKV_DIM), 0.1 * RWKV_W_LORA ** -0.5),
        'rwkv_a0': nrm((L, RWKV_DIM), 0.1),
        'rwkv_a2': nrm((L, RWKV_A_LORA, RWKV_DIM), RWKV_A_LORA ** -0.5),
        'rwkv_g2': nrm((L, RWKV_G_LORA, RWKV_DIM), RWKV_G_LORA ** -0.5),
        'rwkv_k_k': 0.85 + nrm((L, RWKV_DIM), 0.05),
        'rwkv_k_a': gain((L, RWKV_DIM)),
        'rwkv_r_k': nrm((L, RWKV_HEADS, RWKV_HEAD_DIM), 0.1),
        'rwkv_ln_w': gain((L, RWKV_DIM)),
        'rwkv_ln_b': nrm((L, RWKV_DIM), 0.02),
        'mla_q_norm': gain((L, MLA_Q_LORA)),
        'mla_w_uq': nrm((L, MLA_Q_LORA, MLA_HEADS * (MLA_NOPE_DIM + MLA_ROPE_DIM)), MLA_Q_LORA ** -0.5),
        'mla_kv_norm': gain((L, MLA_KV_LORA)),
        'mla_w_ukv': nrm((L, MLA_KV_LORA, MLA_HEADS * (MLA_NOPE_DIM + MLA_V_DIM)), MLA_KV_LORA ** -0.5),
        'diff_lambda': nrm((L, 4, DIFF_QK_DIM), 0.1),
        'diff_subln': gain((L, DIFF_V_DIM)),
        'w_branch_rwkv': nrm((L, RWKV_DIM, D_MODEL), RWKV_DIM ** -0.5),
        'w_branch_mla': nrm((L, MLA_DIM, D_MODEL), MLA_DIM ** -0.5),
        'w_branch_diff': nrm((L, DIFF_DIM, D_MODEL), DIFF_DIM ** -0.5),
        'w_o': nrm((L, D_MODEL, D_MODEL), D_MODEL ** -0.5),
        'norm_ffn': gain((L, D_MODEL)),
        'ffn_w_up': nrm((L, D_MODEL, 2 * D_FF), D_MODEL ** -0.5),
        'ffn_conv_w': nrm((L, CONV_WIDTH, 2 * D_FF), CONV_WIDTH ** -0.5),
        'ffn_conv_b': nrm((L, 2 * D_FF), 0.02),
        'ffn_w_down': nrm((L, D_FF, D_MODEL), D_FF ** -0.5),
        'norm_final': gain((D_MODEL,)),
    }


def reference(x, positions, rel_bias, norm_mix, w_in, b_gate, rwkv_mu, rwkv_w0, rwkv_w2, rwkv_a0,
              rwkv_a2, rwkv_g2, rwkv_k_k, rwkv_k_a, rwkv_r_k, rwkv_ln_w, rwkv_ln_b, mla_q_norm,
              mla_w_uq, mla_kv_norm, mla_w_ukv, diff_lambda, diff_subln, w_branch_rwkv, w_branch_mla,
              w_branch_diff, w_o, norm_ffn, ffn_w_up, ffn_conv_w, ffn_conv_b, ffn_w_down, norm_final):
    B, S, _ = x.shape
    cos, sin = _rope_tables(positions, x.dtype)
    for l in range(DEPTH):
        h = _rmsnorm(x, norm_mix[l])
        p = h @ w_in[l]
        p_rwkv, p_mla, p_diff, p_gate = jnp.split(p, IN_SPLITS, axis=-1)
        o_rwkv = _rwkv7_mix(p_rwkv, rwkv_mu[l], rwkv_w0[l], rwkv_w2[l], rwkv_a0[l], rwkv_a2[l],
                            rwkv_g2[l], rwkv_k_k[l], rwkv_k_a[l], rwkv_r_k[l], rwkv_ln_w[l], rwkv_ln_b[l])
        o_mla = _mla_mix(p_mla, cos, sin, mla_q_norm[l], mla_w_uq[l], mla_kv_norm[l], mla_w_ukv[l])
        o_diff = _diff_mix(p_diff, positions, rel_bias, diff_lambda[l], diff_subln[l], l)
        gates = jax.nn.sigmoid(p_gate + b_gate[l]).reshape(B, S, N_BRANCHES, D_MODEL)
        merged = (gates[:, :, 0] * (o_rwkv @ w_branch_rwkv[l])
                  + gates[:, :, 1] * (o_mla @ w_branch_mla[l])
                  + gates[:, :, 2] * (o_diff @ w_branch_diff[l]))
        x = x + merged @ w_o[l]
        x = x + _conv_ffn(_rmsnorm(x, norm_ffn[l]), ffn_w_up[l], ffn_conv_w[l], ffn_conv_b[l], ffn_w_down[l])
    return _rmsnorm(x, norm_final)
```

```cpp
#include <hip/hip_runtime.h>
#include <hip/hip_cooperative_groups.h>
#include <cstdio>
#include <cstdint>
namespace cg = cooperative_groups;

#define LAS __attribute__((address_space(3)))
typedef unsigned short bf16_t;
typedef short bf16x8 __attribute__((ext_vector_type(8)));
typedef float f32x2 __attribute__((ext_vector_type(2)));
typedef float f32x4 __attribute__((ext_vector_type(4)));
typedef float f32x16 __attribute__((ext_vector_type(16)));
typedef unsigned u32x2 __attribute__((ext_vector_type(2)));
typedef unsigned u32x4 __attribute__((ext_vector_type(4)));

constexpr int NB = 8, S = 4096, D = 1024, DEPTH = 2;
constexpr int GB = 4, NGRP = NB / GB, TG = GB * S;
constexpr int RW_COLS = 1792, MLA_COLS = 416, DF_COLS = 1536, GT_COLS = 3072, IN_COLS = 6816;
constexpr int NP = 6912;
constexpr int DFF = 2816;
constexpr float LOG2E = 1.4426950408889634f;
constexpr float QSCALE_M = 0.10206207261596575f * LOG2E;
constexpr float QSCALE_D = 0.125f * LOG2E;
constexpr int NTHREADS = 512, NWAVES = 8;

constexpr size_t MiB = 1u << 20;
constexpr size_t WS_CTL = 0, WS_ROPE = 1 * MiB, WS_WT = 8 * MiB;
constexpr size_t WT_IN = WS_WT, WT_UQ = WT_IN + (size_t)NP * 1024 * 2, WT_UKV = WT_UQ + 768 * 256 * 2, WT_LORA = WT_UKV + 1024 * 128 * 2,
                 WT_BR = WT_LORA + 1536 * 256 * 2, WT_O = WT_BR + 3 * 1024 * 512 * 2, WT_UP = WT_O + 1024 * 1024 * 2, WT_DN = WT_UP + (size_t)5632 * 1024 * 2,
                 WT_END = WT_DN + (size_t)1024 * DFF * 2;
static_assert(WT_END <= 45 * MiB, "weights");
constexpr size_t WS_HB = 45 * MiB, WS_PRW = 77 * MiB, WS_PML = 133 * MiB, WS_QKD = 149 * MiB, WS_VTD = 181 * MiB, WS_GATE = 197 * MiB,
                 WS_CQN = 293 * MiB, WS_CKVN = 301 * MiB, WS_LIN = 305 * MiB, WS_QM = 313 * MiB, WS_KM = 337 * MiB, WS_VTM = 361 * MiB,
                 WS_WAG = 377 * MiB, WS_ORW = 425 * MiB, WS_OML = 441 * MiB, WS_ODF = 457 * MiB, WS_Y = 473 * MiB, WS_END = 505 * MiB, WS_RKB = 5 * MiB;
constexpr size_t WS_U = 77 * MiB, WS_ACT = 253 * MiB;
static_assert(WS_ACT + (size_t)TG * DFF * 2 <= 512 * MiB && WS_U + (size_t)TG * 5632 * 2 <= WS_ACT, "ffn overlay");

#define GA_ __attribute__((address_space(1)))
template <class T> __device__ __forceinline__ T ldg(const void* p) { return *(const GA_ T*)p; }
template <class T> __device__ __forceinline__ void stg(void* p, T v) { *(GA_ T*)p = v; }
typedef __bf16 bf16x2_native __attribute__((ext_vector_type(2)));
__device__ __forceinline__ unsigned cvt_pk_bf16(float lo, float hi) { const f32x2 v = {lo, hi}; const bf16x2_native b = __builtin_convertvector(v, bf16x2_native); return __builtin_bit_cast(unsigned, b); }
__device__ __forceinline__ float bflo(unsigned w) { return __builtin_bit_cast(float, w << 16); }
__device__ __forceinline__ float bfhi(unsigned w) { return __builtin_bit_cast(float, w & 0xffff0000u); }
__device__ __forceinline__ float bf2f(bf16_t h) { return __builtin_bit_cast(float, (unsigned)h << 16); }
__device__ __forceinline__ bf16_t f2bf(float f) { return (bf16_t)(cvt_pk_bf16(f, 0.f) & 0xffffu); }
__device__ __forceinline__ void store8(bf16_t* p, const float* v) {
    u32x4 w; w.x = cvt_pk_bf16(v[0], v[1]); w.y = cvt_pk_bf16(v[2], v[3]); w.z = cvt_pk_bf16(v[4], v[5]); w.w = cvt_pk_bf16(v[6], v[7]); *(u32x4*)p = w;
}
__device__ __forceinline__ void load8(const bf16_t* p, float* v) {
    const u32x4 w = ldg<u32x4>(p); v[0] = bflo(w.x); v[1] = bfhi(w.x); v[2] = bflo(w.y); v[3] = bfhi(w.y); v[4] = bflo(w.z); v[5] = bfhi(w.z); v[6] = bflo(w.w); v[7] = bfhi(w.w);
}
__device__ __forceinline__ float sigmoidf_(float x) { return __builtin_amdgcn_rcpf(1.f + __expf(-x)); }
__device__ __forceinline__ float wave_sum(float v) {
#pragma unroll
    for (int o = 1; o < 64; o <<= 1) v += __shfl_xor(v, o);
    return v;
}

__device__ __forceinline__ int tid_opaque() { int t; asm volatile("v_mov_b32 %0, %1" : "=v"(t) : "v"((int)threadIdx.x)); __builtin_assume(t >= 0 && t < NTHREADS); return t; }
__device__ __forceinline__ int bid_opaque() { int t; asm volatile("s_mov_b32 %0, %1" : "=s"(t) : "s"((int)blockIdx.x)); __builtin_assume(t >= 0 && t < 1024); return t; }
struct Args { const void* in[33]; float* out; unsigned char* ws; int lo, hi; };
constexpr int ARGS_OFF = 150 * 1024 + 64;
__device__ __forceinline__ unsigned long long uni64(unsigned long long v) { const unsigned lo = __builtin_amdgcn_readfirstlane((unsigned)v), hi = __builtin_amdgcn_readfirstlane((unsigned)(v >> 32)); return ((unsigned long long)hi << 32) | lo; }
struct AP { const LAS unsigned long long* t;
    __device__ __forceinline__ const void* in(int i) const { return (const void*)uni64(t[i]); }
    __device__ __forceinline__ float* out() const { return (float*)uni64(t[33]); }
    __device__ __forceinline__ unsigned char* ws() const { return (unsigned char*)uni64(t[34]); } };
enum { I_X = 0, I_POS, I_RELB, I_NMIX, I_WIN, I_BGATE, I_MU, I_W0, I_W2, I_A0, I_A2, I_G2, I_KK, I_KA, I_RK, I_LNW, I_LNB, I_QNORM, I_WUQ, I_KVNORM, I_WUKV,
       I_LAM, I_SUBLN, I_WBR, I_WBM, I_WBD, I_WO, I_NFFN, I_WUP, I_CW, I_CB, I_WDN, I_NFIN };

#define XB_TMO      128
#define XB_XCNT(j)  (256  + 64 * (j))
#define XB_XSUB(j)  (1280 + 64 * (j))
#define XB_XGEN(j)  (2304 + 64 * (j))
#define XB_TOP      3328
#define XB_TOPGEN   3392
#define XCD_BAR_WORDS 3456
#define XB_SPIN_CAP (1u << 18)

__device__ __forceinline__ unsigned xb_ld(unsigned* p)              { return __hip_atomic_load(p, __ATOMIC_RELAXED, __HIP_MEMORY_SCOPE_AGENT); }
__device__ __forceinline__ unsigned xb_add(unsigned* p, unsigned v) { return __hip_atomic_fetch_add(p, v, __ATOMIC_RELAXED, __HIP_MEMORY_SCOPE_AGENT); }
__device__ __forceinline__ unsigned xb_xcc_id() { return (unsigned)__builtin_amdgcn_s_getreg((3 << 11) | 20) & 0xFu; }
#define XB_SPIN(cond, bar) do { unsigned _sp = 0; while (cond) { __builtin_amdgcn_s_sleep(1); \
    if ((++_sp & 255u) == 0u) { if (xb_ld(&(bar)[XB_TMO])) break; if (_sp > XB_SPIN_CAP) { atomicAdd(&(bar)[XB_TMO], 1u); break; } } } } while (0)

struct XcdBarrier {
    unsigned* bar; unsigned x;
    volatile LAS unsigned* st;
};

__device__ __forceinline__ XcdBarrier xcd_barrier_post(unsigned* bar, volatile LAS unsigned* st) {
    XcdBarrier b; b.bar = bar; b.x = xb_xcc_id(); b.st = st;
    if (threadIdx.x == 0) (void)xb_add(&bar[XB_XCNT(b.x)], 1u);
    return b;
}
__device__ __forceinline__ void xcd_barrier_complete(unsigned* bar, unsigned x, unsigned& nloc, unsigned& nx) {
    const unsigned G = gridDim.x * gridDim.y * gridDim.z;
    unsigned sum, cnt, mine, sp = 0u;
    for (;;) {
        sum = 0u; cnt = 0u; mine = 0u;
#pragma unroll
        for (unsigned j = 0; j < 16; ++j) { const unsigned c = xb_ld(&bar[XB_XCNT(j)]); sum += c; cnt += (c > 0u) ? 1u : 0u; mine = (j == x) ? c : mine; }
        if (sum == G) break;
        __builtin_amdgcn_s_sleep(1);
        if ((++sp & 255u) == 0u) { if (xb_ld(&bar[XB_TMO])) break; if (sp > XB_SPIN_CAP) { atomicAdd(&bar[XB_TMO], 1u); break; } }
    }
    nloc = mine > 0u ? mine : 1u; nx = cnt > 0u ? cnt : 1u;
}

__device__ __forceinline__ void xcd_barrier(const XcdBarrier& b) {
    asm volatile("s_waitcnt vmcnt(0)" ::: "memory");
    __syncthreads();
    if (threadIdx.x == 0) {
        unsigned* bar = b.bar;
        __builtin_amdgcn_s_waitcnt(0);
        unsigned nloc = b.st[0], nx = b.st[1];
        if (nloc == 0u) { xcd_barrier_complete(bar, b.x, nloc, nx); b.st[0] = nloc; b.st[1] = nx; }
        const unsigned old = xb_add(&bar[XB_XSUB(b.x)], 1u);
        const unsigned gen = old / nloc;
        if (old + 1u == (gen + 1u) * nloc) {
            __builtin_amdgcn_fence(__ATOMIC_RELEASE, "agent");
            asm volatile("s_waitcnt vmcnt(0)" ::: "memory");
            const unsigned og = xb_add(&bar[XB_TOP], 1u);
            const unsigned tg = og / nx;
            if (og + 1u == (tg + 1u) * nx) xb_add(&bar[XB_TOPGEN], 1u);
            else XB_SPIN(xb_ld(&bar[XB_TOPGEN]) == tg, bar);
            __builtin_amdgcn_fence(__ATOMIC_ACQUIRE, "agent");
            xb_add(&bar[XB_XGEN(b.x)], 1u);
            asm volatile("s_waitcnt vmcnt(0)" ::: "memory");
        } else {
            XB_SPIN(xb_ld(&bar[XB_XGEN(b.x)]) == gen, bar);
            __builtin_amdgcn_fence(__ATOMIC_ACQUIRE, "agent");
            asm volatile("s_waitcnt vmcnt(0)" ::: "memory");
        }
    }
    __syncthreads();
}

struct WSrc { const float* p; int ld; };
__device__ __forceinline__ WSrc wt_src(const AP a, int l, int wid, int kb, int n) {
    WSrc r; r.p = nullptr; r.ld = 0;
    const int k0 = kb * 64;
    switch (wid) {
    case 0: { const float* w = (const float*)a.in(I_WIN) + (size_t)l * 1024 * IN_COLS; int col;
              if (n < 1792) col = n; else if (n < 2304) { col = (n - 1792 < MLA_COLS) ? n : -1; } else if (n < 3840) col = 2208 + (n - 2304); else col = 3744 + (n - 3840);
              if (col >= 0) { r.p = w + (size_t)k0 * IN_COLS + col; r.ld = IN_COLS; } } break;
    case 1: { const float* w = (const float*)a.in(I_WUQ) + (size_t)l * 256 * 768; const int hd = n / 96, ww = n % 96; int col = n;
              if (ww >= 64) { const int i = (ww - 64) >> 1, p = (ww - 64) & 1; col = hd * 96 + 64 + i + 16 * p; }
              r.p = w + (size_t)k0 * 768 + col; r.ld = 768; } break;
    case 2: { const float* w = (const float*)a.in(I_WUKV) + (size_t)l * 128 * 1024; r.p = w + (size_t)k0 * 1024 + n; r.ld = 1024; } break;
    case 3: { if (n < 512) { if (kb == 0) { r.p = (const float*)a.in(I_W2) + (size_t)l * 64 * 512 + n; r.ld = 512; } }
              else if (n < 1024) { if (kb == 1) { r.p = (const float*)a.in(I_A2) + (size_t)l * 64 * 512 + (n - 512); r.ld = 512; } }
              else { if (kb >= 2) { r.p = (const float*)a.in(I_G2) + (size_t)l * 128 * 512 + (size_t)(k0 - 128) * 512 + (n - 1024); r.ld = 512; } } } break;
    case 4: case 5: case 6: { const float* w = (const float*)a.in(I_WBR + (wid - 4)) + (size_t)l * 512 * 1024; r.p = w + (size_t)k0 * 1024 + n; r.ld = 1024; } break;
    case 7: { const float* w = (const float*)a.in(I_WO) + (size_t)l * 1024 * 1024; r.p = w + (size_t)k0 * 1024 + n; r.ld = 1024; } break;
    case 8: { const float* w = (const float*)a.in(I_WUP) + (size_t)l * 1024 * 5632; r.p = w + (size_t)k0 * 5632 + n; r.ld = 5632; } break;
    default: { const float* w = (const float*)a.in(I_WDN) + (size_t)l * DFF * 1024; r.p = w + (size_t)k0 * 1024 + n; r.ld = 1024; } break;
    }
    return r;
}
__device__ __forceinline__ void wt_convert(const AP a, int l, LAS float* scr, int gw, int ngw, int lane) {
    constexpr int NWT = 10;
    int base = 0;
#pragma unroll 1
    for (int w = 0; w < NWT; ++w) {
        int Npw, K; size_t offw;
        switch (w) {
        case 0: Npw = NP; K = 1024; offw = WT_IN; break;
        case 1: Npw = 768; K = 256; offw = WT_UQ; break;
        case 2: Npw = 1024; K = 128; offw = WT_UKV; break;
        case 3: Npw = 1536; K = 256; offw = WT_LORA; break;
        case 4: Npw = 1024; K = 512; offw = WT_BR; break;
        case 5: Npw = 1024; K = 512; offw = WT_BR + 1024 * 512 * 2; break;
        case 6: Npw = 1024; K = 512; offw = WT_BR + 2 * 1024 * 512 * 2; break;
        case 7: Npw = 1024; K = 1024; offw = WT_O; break;
        case 8: Npw = 5632; K = 1024; offw = WT_UP; break;
        default: Npw = 1024; K = DFF; offw = WT_DN; break;
        }
        const int nblk = Npw / 32, nitems = (K / 64) * nblk;
        bf16_t* WT = (bf16_t*)(a.ws() + offw);
        int it = gw - (base % ngw); if (it < 0) it += ngw;
#pragma unroll 1
        for (; it < nitems; it += ngw) {
            const int kb = it / nblk, nb = it % nblk, k0 = 64 * kb, n0 = 32 * nb;
            const WSrc s = wt_src(a, l, w, kb, n0 + (lane & 31));
#pragma unroll 8
            for (int i = 0; i < 32; ++i) { const int kk = 2 * i + (lane >> 5); scr[kk * 33 + (lane & 31)] = s.p ? s.p[(size_t)kk * s.ld] : 0.f; }
            asm volatile("s_waitcnt lgkmcnt(0)" ::: "memory");
            const int c = lane & 7;
#pragma unroll
            for (int j = 0; j < 4; ++j) { const int n = (lane >> 3) + 8 * j; const LAS float* sp = scr + (8 * c) * 33 + n;
                u32x4 o; o.x = cvt_pk_bf16(sp[0 * 33], sp[1 * 33]); o.y = cvt_pk_bf16(sp[2 * 33], sp[3 * 33]); o.z = cvt_pk_bf16(sp[4 * 33], sp[5 * 33]); o.w = cvt_pk_bf16(sp[6 * 33], sp[7 * 33]);
                stg<u32x4>(WT + (size_t)(n0 + n) * K + k0 + 8 * c, o); }
            asm volatile("s_waitcnt lgkmcnt(0)" ::: "memory");
        }
        base += nitems;
    }
}

__device__ __forceinline__ void rmsnorm_rows(const float* x, const float* gain, bf16_t* o, int nrows, int gw, int ngw, int lane) {
    f32x4 gv[4];
#pragma unroll
    for (int j = 0; j < 4; ++j) gv[j] = ldg<f32x4>((const f32x4*)gain + lane + 64 * j);
#pragma unroll 1
    for (int r = gw; r < nrows; r += 2 * ngw) {
        const int r2 = r + ngw; const bool has2 = r2 < nrows; const int rb = has2 ? r2 : r;
        const f32x4* xa = (const f32x4*)(x + (size_t)r * D) + lane; const f32x4* xb = (const f32x4*)(x + (size_t)rb * D) + lane; f32x4 va[4], vb[4]; float sa = 0.f, sb = 0.f;
#pragma unroll
        for (int j = 0; j < 4; ++j) { va[j] = ldg<f32x4>(xa + 64 * j); vb[j] = ldg<f32x4>(xb + 64 * j); }
#pragma unroll
        for (int j = 0; j < 4; ++j) { sa += (va[j].x * va[j].x + va[j].y * va[j].y) + (va[j].z * va[j].z + va[j].w * va[j].w); sb += (vb[j].x * vb[j].x + vb[j].y * vb[j].y) + (vb[j].z * vb[j].z + vb[j].w * vb[j].w); }
#pragma unroll
        for (int of = 1; of < 64; of <<= 1) { sa += __shfl_xor(sa, of); sb += __shfl_xor(sb, of); }
        const float ra = rsqrtf(sa * (1.f / D) + 1e-6f), rbb = rsqrtf(sb * (1.f / D) + 1e-6f);
        u32x2* oa = (u32x2*)(o + (size_t)r * D) + lane; u32x2* ob = (u32x2*)(o + (size_t)rb * D) + lane;
#pragma unroll
        for (int j = 0; j < 4; ++j) { u32x2 w; w.x = cvt_pk_bf16(va[j].x * ra * gv[j].x, va[j].y * ra * gv[j].y); w.y = cvt_pk_bf16(va[j].z * ra * gv[j].z, va[j].w * ra * gv[j].w); stg<u32x2>(oa + 64 * j, w); }
        if (has2) {
#pragma unroll
            for (int j = 0; j < 4; ++j) { u32x2 w; w.x = cvt_pk_bf16(vb[j].x * rbb * gv[j].x, vb[j].y * rbb * gv[j].y); w.y = cvt_pk_bf16(vb[j].z * rbb * gv[j].z, vb[j].w * rbb * gv[j].w); stg<u32x2>(ob + 64 * j, w); } }
    }
}
__device__ __forceinline__ void rmsnorm_rows_f32(float* x, const float* gain, int nrows, int gw, int ngw, int lane) {
    f32x4 gv[4];
#pragma unroll
    for (int j = 0; j < 4; ++j) gv[j] = *((const f32x4*)gain + lane + 64 * j);
#pragma unroll 1
    for (int r = gw; r < nrows; r += ngw) {
        f32x4* xr = (f32x4*)(x + (size_t)r * D) + lane; f32x4 v[4]; float s = 0.f;
#pragma unroll
        for (int j = 0; j < 4; ++j) { v[j] = xr[64 * j]; s += (v[j].x * v[j].x + v[j].y * v[j].y) + (v[j].z * v[j].z + v[j].w * v[j].w); }
        const float rs = rsqrtf(wave_sum(s) * (1.f / D) + 1e-6f);
#pragma unroll
        for (int j = 0; j < 4; ++j) xr[64 * j] = v[j] * rs * gv[j];
    }
}
namespace pg8 {
#define PG8_LAS __attribute__((address_space(3)))
constexpr int BM = 256, BK = 64, HALF = 128, HTB = HALF * BK * 2  , STAGE_BYTES = 8 * HTB, NXCD = 8, WGM = 8;

__host__ __device__ __forceinline__ int lds_byte(int r, int c) { const int st = (r >> 4) * 2 + (c >> 5), rr = r & 15, cc = c & 31, ob = rr * 64 + cc * 2; return st * 1024 + (ob ^ (((ob >> 9) & 1) << 5)); }
__host__ __device__ __forceinline__ void stage_rc(int b, int& R, int& C) { const int st = b / 1024, sb = b % 1024, swz = sb ^ (((sb >> 9) & 1) << 5); R = (st >> 1) * 16 + swz / 64; C = (st & 1) * 32 + (swz % 64) / 2; }
__host__ __device__ __forceinline__ int perm32(int rho) { const int n = rho >> 4, i = rho & 15; return 8 * (i >> 2) + 4 * n + (i & 3); }

struct Unit { int pm, pn, br; };
struct Gemm { const bf16_t* A; const bf16_t* Bt; int M, N, K, lda; size_t brA, brB; };

struct StaticOrder {
    int nM, nN, nwg, G, c, nbr;
    __host__ __device__ void init(int M, int N, int G_, int c_) { nM = M / BM; nN = N / BM; nwg = nM * nN; G = G_; c = c_; nbr = 1; }
    __host__ __device__ bool next(int i, Unit& u) const {
        const int it = i / nbr; u.br = i - it * nbr;
        const long L = (long)it * G + c; if (L >= nwg) return false;
        int wgid = (int)L; { const int q = nwg / NXCD, r = nwg % NXCD, xcd = wgid % NXCD, off = wgid / NXCD; wgid = (xcd < r ? xcd * (q + 1) : r * (q + 1) + (xcd - r) * q) + off; }
        const int nig = WGM * nN, gid = wgid / nig, fm = gid * WGM, gsz = (nM - fm) < WGM ? (nM - fm) : WGM;
        u.pm = fm + ((wgid % nig) % gsz); u.pn = (wgid % nig) / gsz; return true;
    }
    __device__ __forceinline__ void a_ready(const Unit&) const {}
    __device__ __forceinline__ void done(const Unit&) const {}
};

template <class Epi, class Sched, bool ALIGN_EPI = false, bool SP2 = false>
__device__ __forceinline__ void gemm_phase(PG8_LAS unsigned char* lds, const Gemm g, const Sched& S, const Epi& E) {
    const int tid = tid_opaque(), wid = __builtin_amdgcn_readfirstlane(tid >> 6), lane = tid & 63, wr = wid >> 2, wc = wid & 3, fr = lane & 15, fq = lane >> 4;
    const int K = g.K, nt = K / BK;
    unsigned voffA[2], voffB[2];
#pragma unroll
    for (int i = 0; i < 2; ++i) { int R, C; stage_rc(tid * 16 + i * 8192, R, C); const int Rb = Epi::PERM ? ((R & ~31) + perm32(R & 31)) : R;
        voffA[i] = (unsigned)(R * g.lda + C) * 2u; voffB[i] = (unsigned)(Rb * K + C) * 2u; }
    const size_t kstep = (size_t)(BK * 2);
    const size_t hstepB = (size_t)HALF * K * 2, tstepB = 2 * hstepB;
    const size_t hstepA = (size_t)HALF * g.lda * 2, tstepA = 2 * hstepA;
    const unsigned ldsw = (unsigned)wid * 1024u;
    const int aoff = lds_byte(wr * 64 + fr, fq * 8), boff = lds_byte(wc * 32 + fr, fq * 8);
#define PG8_SA(b, h) (((b) * 2 + (h)) * HTB)
#define PG8_SB(b, h) ((4 + (b) * 2 + (h)) * HTB)
#define PG8_STAGE(bufoff, gbase, voff) do { _Pragma("unroll") for (int _i = 0; _i < 2; ++_i) \
        __builtin_amdgcn_global_load_lds((const unsigned*)((const char*)(gbase) + (voff)[_i]), (PG8_LAS unsigned*)(lds + (bufoff) + ldsw + _i * 8192), 16, 0, 0); } while (0)
#define PG8_LDA(dst, b, h) do { _Pragma("unroll") for (int m = 0; m < 4; ++m) _Pragma("unroll") for (int k = 0; k < 2; ++k) dst[m][k] = *(const PG8_LAS bf16x8*)(lds + PG8_SA(b, h) + aoff + m * 2048 + k * 1024); } while (0)
#define PG8_LDB(dst, b, h) do { _Pragma("unroll") for (int n = 0; n < 2; ++n) _Pragma("unroll") for (int k = 0; k < 2; ++k) dst[n][k] = *(const PG8_LAS bf16x8*)(lds + PG8_SB(b, h) + boff + n * 2048 + k * 1024); } while (0)
#define PG8_MMA(ai, bj, At, Bt) do { __builtin_amdgcn_s_setprio(1); _Pragma("unroll") for (int m = 0; m < 4; ++m) _Pragma("unroll") for (int n = 0; n < 2; ++n) _Pragma("unroll") for (int k = 0; k < 2; ++k) \
        acc[ai][bj][m][n] = __builtin_amdgcn_mfma_f32_16x16x32_bf16(Bt[n][k], At[m][k], acc[ai][bj][m][n], 0, 0, 0); __builtin_amdgcn_s_setprio(0); } while (0)
#define PG8_WAIT_V(n) asm volatile("s_waitcnt vmcnt(" #n ")" ::: "memory")
#define PG8_WAIT_L(n) asm volatile("s_waitcnt lgkmcnt(" #n ")" ::: "memory")
#define PG8_BAR __builtin_amdgcn_s_barrier()
#define PG8_SCHED __builtin_amdgcn_sched_barrier(0)
    Unit cur, nxt; int ui = 0;
    if (!S.next(0, cur)) return;
    f32x4 acc[2][2][4][2];
#pragma unroll
    for (int a = 0; a < 2; ++a)
#pragma unroll
        for (int b = 0; b < 2; ++b)
#pragma unroll
            for (int m = 0; m < 4; ++m)
#pragma unroll
                for (int n = 0; n < 2; ++n) acc[a][b][m][n] = (f32x4){0.f, 0.f, 0.f, 0.f};
    bf16x8 At[4][2], B0[2][2], B1[2][2];
    const char* cA = (const char*)g.A + (size_t)cur.pm * tstepA + (size_t)cur.br * g.brA; const char* cB = (const char*)g.Bt + (size_t)cur.pn * tstepB + (size_t)cur.br * g.brB;
    S.a_ready(cur);
    if constexpr (SP2) {
        PG8_STAGE(PG8_SB(0, 0), cB, voffB); PG8_STAGE(PG8_SB(0, 1), cB + hstepB, voffB); PG8_STAGE(PG8_SA(0, 0), cA, voffA); PG8_STAGE(PG8_SA(0, 1), cA + hstepA, voffA);
        if (wr == 1) PG8_BAR;
        PG8_WAIT_V(2); PG8_BAR;
        PG8_STAGE(PG8_SB(1, 0), cB + kstep, voffB); PG8_STAGE(PG8_SA(1, 0), cA + kstep, voffA); PG8_STAGE(PG8_SB(1, 1), cB + hstepB + kstep, voffB);
        PG8_WAIT_V(6); PG8_BAR;
    } else {
        PG8_STAGE(PG8_SB(0, 0), cB, voffB); PG8_STAGE(PG8_SA(0, 0), cA, voffA); PG8_STAGE(PG8_SB(0, 1), cB + hstepB, voffB); PG8_STAGE(PG8_SA(0, 1), cA + hstepA, voffA);
        if (wr == 1) PG8_BAR;
        PG8_WAIT_V(4); PG8_BAR;
        PG8_STAGE(PG8_SB(1, 0), cB + kstep, voffB); PG8_STAGE(PG8_SA(1, 0), cA + kstep, voffA); PG8_STAGE(PG8_SB(1, 1), cB + hstepB + kstep, voffB);
        PG8_WAIT_V(6); PG8_BAR;
    }
    for (;;) {
        const bool has_next = S.next(ui + 1, nxt);
        const char* nA = has_next ? (const char*)g.A + (size_t)nxt.pm * tstepA + (size_t)nxt.br * g.brA : cA; const char* nB = has_next ? (const char*)g.Bt + (size_t)nxt.pn * tstepB + (size_t)nxt.br * g.brB : cB;
        for (int t = 0; t < nt; t += 2) {
            const bool last = (t == nt - 2);
            const char* a1 = cA + (size_t)(t + 1) * kstep;
            const char* a2 = last ? nA : cA + (size_t)(t + 2) * kstep; const char* b2 = last ? nB : cB + (size_t)(t + 2) * kstep;
            const char* a3 = a2 + kstep; const char* b3 = b2 + kstep;
            if (last && has_next) S.a_ready(nxt);
            if constexpr (SP2) {
            PG8_LDB(B0, 0, 0); PG8_LDB(B1, 0, 1); PG8_SCHED; PG8_LDA(At, 0, 0); PG8_STAGE(PG8_SA(1, 1), a1 + hstepA, voffA);
            PG8_WAIT_V(8); PG8_WAIT_L(0); PG8_BAR; PG8_MMA(0, 0, At, B0); PG8_MMA(0, 1, At, B1); PG8_BAR; PG8_SCHED;
            PG8_LDA(At, 0, 1); PG8_STAGE(PG8_SB(0, 0), b2, voffB); PG8_STAGE(PG8_SB(0, 1), b2 + hstepB, voffB); PG8_STAGE(PG8_SA(0, 0), a2, voffA);
            PG8_WAIT_V(8); PG8_WAIT_L(0); PG8_BAR; PG8_MMA(1, 0, At, B0); PG8_MMA(1, 1, At, B1); PG8_BAR; PG8_SCHED;
            PG8_LDB(B0, 1, 0); PG8_LDB(B1, 1, 1); PG8_SCHED; PG8_LDA(At, 1, 0); PG8_STAGE(PG8_SA(0, 1), a2 + hstepA, voffA);
            PG8_WAIT_V(8); PG8_WAIT_L(0); PG8_BAR; PG8_MMA(0, 0, At, B0); PG8_MMA(0, 1, At, B1); PG8_BAR; PG8_SCHED;
            PG8_LDA(At, 1, 1); PG8_STAGE(PG8_SB(1, 0), b3, voffB); PG8_STAGE(PG8_SB(1, 1), b3 + hstepB, voffB); PG8_STAGE(PG8_SA(1, 0), a3, voffA);
            PG8_WAIT_V(8); PG8_WAIT_L(0); PG8_BAR; PG8_MMA(1, 0, At, B0); PG8_MMA(1, 1, At, B1); PG8_BAR; PG8_SCHED;
            } else {
            PG8_LDB(B0, 0, 0); PG8_SCHED; PG8_LDA(At, 0, 0); PG8_STAGE(PG8_SA(1, 1), a1 + hstepA, voffA);
            PG8_WAIT_L(8); PG8_BAR; PG8_WAIT_L(0); PG8_MMA(0, 0, At, B0); PG8_BAR; PG8_SCHED;
            PG8_LDB(B1, 0, 1); PG8_STAGE(PG8_SB(0, 0), b2, voffB);
            PG8_BAR; PG8_WAIT_L(0); PG8_MMA(0, 1, At, B1); PG8_BAR;
            PG8_LDA(At, 0, 1); PG8_STAGE(PG8_SA(0, 0), a2, voffA);
            PG8_BAR; PG8_WAIT_L(0); PG8_MMA(1, 0, At, B0); PG8_BAR; PG8_SCHED;
            PG8_STAGE(PG8_SB(0, 1), b2 + hstepB, voffB);
            PG8_WAIT_V(6); PG8_BAR; PG8_MMA(1, 1, At, B1); PG8_BAR;
            PG8_LDB(B0, 1, 0); PG8_SCHED; PG8_LDA(At, 1, 0); PG8_STAGE(PG8_SA(0, 1), a2 + hstepA, voffA);
            PG8_WAIT_L(8); PG8_BAR; PG8_WAIT_L(0); PG8_MMA(0, 0, At, B0); PG8_BAR; PG8_SCHED;
            PG8_LDB(B1, 1, 1); PG8_STAGE(PG8_SB(1, 0), b3, voffB);
            PG8_BAR; PG8_WAIT_L(0); PG8_MMA(0, 1, At, B1); PG8_BAR;
            PG8_LDA(At, 1, 1); PG8_STAGE(PG8_SA(1, 0), a3, voffA);
            PG8_BAR; PG8_WAIT_L(0); PG8_MMA(1, 0, At, B0); PG8_BAR; PG8_SCHED;
            PG8_STAGE(PG8_SB(1, 1), b3 + hstepB, voffB);
            PG8_WAIT_V(6); PG8_BAR; PG8_MMA(1, 1, At, B1); PG8_BAR;
            }
        }
        if constexpr (ALIGN_EPI) { if (wr == 0) PG8_BAR; }
        bool keep_acc = false;
        if constexpr (!Epi::AFTER_DRAIN) { keep_acc = E.apply(acc, cur, wr, wc, fr, fq); S.done(cur); }
        if (!has_next) break;
        if (!keep_acc) {
#pragma unroll
        for (int a = 0; a < 2; ++a)
#pragma unroll
            for (int b = 0; b < 2; ++b)
#pragma unroll
                for (int m = 0; m < 4; ++m)
#pragma unroll
                    for (int n = 0; n < 2; ++n) acc[a][b][m][n] = (f32x4){0.f, 0.f, 0.f, 0.f};
        }
        cur = nxt; cA = nA; cB = nB; ++ui;
        if constexpr (ALIGN_EPI) { if (wr == 1) PG8_BAR; }
    }
    PG8_WAIT_V(0);
    if constexpr (!ALIGN_EPI) { if (wr == 0) PG8_BAR; }
    PG8_BAR;
    if constexpr (Epi::AFTER_DRAIN) { E.fused(acc, cur, wr, wc, fr, fq, lds, wid, lane); S.done(cur); }
#undef PG8_SA
#undef PG8_SB
#undef PG8_STAGE
#undef PG8_LDA
#undef PG8_LDB
#undef PG8_MMA
#undef PG8_WAIT_V
#undef PG8_WAIT_L
#undef PG8_BAR
#undef PG8_SCHED
}
}


enum { K_P = 0, K_Q, K_KV, K_LORA, K_BR, K_WO, K_UP, K_DN, K_BR3 };
struct Epi {
    static constexpr bool PERM = true, AFTER_DRAIN = false;
    int kind, aux, grp, pad;
    unsigned char* ws;
    const float* f0; const float* f1;
    const float* xi; float* xo;
    __device__ __forceinline__ void emit(int row, int pn, int col0, float* v) const {
        switch (kind) {
        case K_P: {
            if (pn < 7) store8((bf16_t*)(ws + WS_PRW) + (size_t)row * RW_COLS + col0, v);
            else if (pn < 9) store8((bf16_t*)(ws + WS_PML) + (size_t)row * 512 + (col0 - 1792), v);
            else if (pn < 13) { const int cq = col0 - 2304; if (cq < 512) {
#pragma unroll
                    for (int j = 0; j < 8; ++j) v[j] *= QSCALE_D; }
                store8((bf16_t*)(ws + WS_QKD) + (size_t)row * 1024 + cq, v); }
            else if (pn < 15) { const int cv = col0 - 3328, hh = cv >> 7, dv = cv & 127, bl = row >> 12, s = row & 4095;
                bf16_t* p = (bf16_t*)(ws + WS_VTD) + ((size_t)(bl * 4 + hh) * 128 + dv) * S + s;
#pragma unroll
                for (int j = 0; j < 8; ++j) p[(size_t)j * S] = f2bf(v[j]); }
            else { const int cg_ = col0 - 3840; const f32x4 b0 = ldg<f32x4>(f0 + cg_), b1 = ldg<f32x4>(f0 + cg_ + 4);
                v[0] = sigmoidf_(v[0] + b0.x); v[1] = sigmoidf_(v[1] + b0.y); v[2] = sigmoidf_(v[2] + b0.z); v[3] = sigmoidf_(v[3] + b0.w);
                v[4] = sigmoidf_(v[4] + b1.x); v[5] = sigmoidf_(v[5] + b1.y); v[6] = sigmoidf_(v[6] + b1.z); v[7] = sigmoidf_(v[7] + b1.w);
                store8((bf16_t*)(ws + WS_GATE) + (size_t)row * GT_COLS + cg_, v); }
        } break;
        case K_Q: {
            const int hd = col0 / 96, w = col0 - hd * 96, bl = row >> 12, s = row & 4095;
            if (w >= 64) { const f32x2* rt = (const f32x2*)(ws + WS_ROPE) + ((size_t)(grp * GB + bl) * S + s) * 16 + ((w - 64) >> 1);
#pragma unroll
                for (int jj = 0; jj < 4; ++jj) { const f32x2 cs = rt[jj]; const float x1 = v[2 * jj], x2 = v[2 * jj + 1]; v[2 * jj] = x1 * cs.x - x2 * cs.y; v[2 * jj + 1] = x1 * cs.y + x2 * cs.x; } }
#pragma unroll
            for (int j = 0; j < 8; ++j) v[j] *= QSCALE_M;
            store8((bf16_t*)(ws + WS_QM) + ((size_t)(bl * 8 + hd) * S + s) * 96 + w, v);
        } break;
        case K_KV: {
            const int hd = col0 >> 7, w = col0 & 127, bl = row >> 12, s = row & 4095;
            if (w < 64) store8((bf16_t*)(ws + WS_KM) + ((size_t)(bl * 8 + hd) * S + s) * 96 + w, v);
            else { bf16_t* p = (bf16_t*)(ws + WS_VTM) + ((size_t)(bl * 8 + hd) * 64 + (w - 64)) * S + s;
#pragma unroll
                for (int j = 0; j < 8; ++j) p[(size_t)j * S] = f2bf(v[j]); }
        } break;
        case K_LORA: {
            if (col0 < 512) {
#pragma unroll
                for (int j = 0; j < 8; ++j) v[j] = 0.6065306597126334f * sigmoidf_(v[j] + f0[col0 + j]); }
            else if (col0 < 1024) {
#pragma unroll
                for (int j = 0; j < 8; ++j) v[j] = sigmoidf_(v[j] + f1[col0 - 512 + j]); }
            store8((bf16_t*)(ws + WS_WAG) + (size_t)row * 1536 + col0, v);
        } break;
        case K_BR: {
            float gt[8]; load8((const bf16_t*)(ws + WS_GATE) + (size_t)row * GT_COLS + aux * 1024 + col0, gt);
            bf16_t* mp = (bf16_t*)(ws + WS_HB) + (size_t)row * 1024 + col0;
            if (aux > 0) { float o[8]; load8(mp, o);
#pragma unroll
                for (int j = 0; j < 8; ++j) v[j] = o[j] + gt[j] * v[j]; }
            else {
#pragma unroll
                for (int j = 0; j < 8; ++j) v[j] = gt[j] * v[j]; }
            store8(mp, v);
        } break;
        case K_WO: case K_DN: {
            const size_t o = ((size_t)grp * TG + row) * D + col0;
            const f32x4 a0 = ldg<f32x4>(xi + o), a1 = ldg<f32x4>(xi + o + 4);
            f32x4 r0, r1; r0.x = a0.x + v[0]; r0.y = a0.y + v[1]; r0.z = a0.z + v[2]; r0.w = a0.w + v[3]; r1.x = a1.x + v[4]; r1.y = a1.y + v[5]; r1.z = a1.z + v[6]; r1.w = a1.w + v[7];
            stg<f32x4>(xo + o, r0); stg<f32x4>(xo + o + 4, r1);
        } break;
        default: {
            store8((bf16_t*)(ws + WS_U) + (size_t)row * 5632 + col0, v);
        } break;
        }
    }
    __device__ __forceinline__ bool apply(f32x4 (&acc)[2][2][4][2], const pg8::Unit& u, int wr, int wc, int fr, int fq) const {
        if (kind != K_BR3) { (*this)(acc, u, wr, wc, fr, fq); return false; }
        const int row0 = u.pm * 256 + wr * 64 + fr, colb = u.pn * 256 + wc * 32 + 8 * fq, br = u.br;
        const bf16_t* G = (const bf16_t*)(ws + WS_GATE); bf16_t* Mb = (bf16_t*)(ws + WS_HB);
#pragma unroll
        for (int ai = 0; ai < 2; ++ai)
#pragma unroll
            for (int m = 0; m < 4; ++m)
#pragma unroll
                for (int bj = 0; bj < 2; ++bj) { const int row = row0 + ai * 128 + m * 16, col0 = colb + bj * 128;
                    float gc[8], gn[8]; load8(G + (size_t)row * GT_COLS + br * 1024 + col0, gc);
                    if (br < 2) load8(G + (size_t)row * GT_COLS + (br + 1) * 1024 + col0, gn);
                    else {
#pragma unroll
                        for (int j = 0; j < 8; ++j) gn[j] = 1.f; }
                    float v[8]; const f32x4 v0 = acc[ai][bj][m][0], v1 = acc[ai][bj][m][1];
                    v[0] = v0.x; v[1] = v0.y; v[2] = v0.z; v[3] = v0.w; v[4] = v1.x; v[5] = v1.y; v[6] = v1.z; v[7] = v1.w;
#pragma unroll
                    for (int j = 0; j < 8; ++j) v[j] *= fmaxf(gc[j], 1e-4f);
                    if (br == 2) store8(Mb + (size_t)row * 1024 + col0, v);
                    else {
#pragma unroll
                        for (int j = 0; j < 8; ++j) v[j] *= __builtin_amdgcn_rcpf(fmaxf(gn[j], 1e-4f));
                        acc[ai][bj][m][0] = (f32x4){v[0], v[1], v[2], v[3]}; acc[ai][bj][m][1] = (f32x4){v[4], v[5], v[6], v[7]}; }
                }
        return br < 2;
    }
    __device__ __forceinline__ void operator()(const f32x4 (&acc)[2][2][4][2], const pg8::Unit& u, int wr, int wc, int fr, int fq) const {
        const int row0 = u.pm * 256 + wr * 64 + fr, colb = u.pn * 256 + wc * 32 + 8 * fq;
#pragma unroll
        for (int ai = 0; ai < 2; ++ai)
#pragma unroll
            for (int m = 0; m < 4; ++m)
#pragma unroll
                for (int bj = 0; bj < 2; ++bj) {
                    float v[8]; const f32x4 v0 = acc[ai][bj][m][0], v1 = acc[ai][bj][m][1];
                    v[0] = v0.x; v[1] = v0.y; v[2] = v0.z; v[3] = v0.w; v[4] = v1.x; v[5] = v1.y; v[6] = v1.z; v[7] = v1.w;
                    emit(row0 + ai * 128 + m * 16, u.pn, colb + bj * 128, v);
                }
    }
};
struct SingleOrder { int pm, pn, cnt;
    __device__ __forceinline__ bool next(int i, pg8::Unit& u) const { if (i >= cnt) return false; u.pm = pm; u.pn = pn + i; u.br = 0; return true; }
    __device__ __forceinline__ void a_ready(const pg8::Unit&) const {}
    __device__ __forceinline__ void done(const pg8::Unit&) const {} };
__device__ __forceinline__ void run_gemm_unit(LAS unsigned char* lds, const bf16_t* A, int lda, const bf16_t* Bt, int M, int N, int K, const Epi& E, int pm, int pn, int cnt) {
    pg8::Gemm g{A, Bt, M, N, K, lda}; SingleOrder So; So.pm = pm; So.pn = pn; So.cnt = cnt;
    pg8::gemm_phase<Epi, SingleOrder, false, true>((PG8_LAS unsigned char*)lds, g, So, E);
}
__device__ __forceinline__ void run_gemm(LAS unsigned char* lds, const bf16_t* A, int lda, const bf16_t* Bt, int M, int N, int K, const Epi& E, int nbr, size_t brA, size_t brB) {
    pg8::Gemm g{A, Bt, M, N, K, lda, brA, brB}; pg8::StaticOrder So; So.init(M, N, (int)gridDim.x, bid_opaque()); So.nbr = nbr;
    pg8::gemm_phase<Epi, pg8::StaticOrder, true, true>((PG8_LAS unsigned char*)lds, g, So, E);
}

__device__ __forceinline__ void prologue_phase(const AP a) {
    const int gt = bid_opaque() * NTHREADS + tid_opaque(), ngt = gridDim.x * NTHREADS;
    const int* pos = (const int*)a.in(I_POS);
    f32x2* rt = (f32x2*)(a.ws() + WS_ROPE);
    for (int i = gt; i < NB * S * 16; i += ngt) {
        const int f = i & 15; const float inv = powf(10000.f, -(float)(2 * f) / 32.f);
        const float ang = (float)pos[i >> 4] * inv; float sn, cs; sincosf(ang, &sn, &cs);
        f32x2 o; o.x = cs; o.y = sn; rt[i] = o;
    }
    if (gt < 64) ((unsigned*)(a.ws() + WS_CTL))[gt] = 0u;
}

__device__ __forceinline__ void c1_phase(const AP a, int l, int grp, int gw, int ngw, int lane) {
    const bf16_t* PML = (const bf16_t*)(a.ws() + WS_PML); const bf16_t* PRW = (const bf16_t*)(a.ws() + WS_PRW);
    bf16_t* CQN = (bf16_t*)(a.ws() + WS_CQN); bf16_t* CKVN = (bf16_t*)(a.ws() + WS_CKVN); bf16_t* LIN = (bf16_t*)(a.ws() + WS_LIN); bf16_t* KM = (bf16_t*)(a.ws() + WS_KM);
    const float* qn = (const float*)a.in(I_QNORM) + l * 256; const float* kvn = (const float*)a.in(I_KVNORM) + l * 128; const float* mu = (const float*)a.in(I_MU) + l * RW_COLS + 1536;
    const f32x2* rt = (const f32x2*)(a.ws() + WS_ROPE);
    const f32x4 qg = ldg<f32x4>(qn + 4 * lane); const f32x2 kg = ldg<f32x2>(kvn + 2 * lane); const f32x4 mu4 = ldg<f32x4>(mu + 4 * lane);
#pragma unroll 2
    for (int row = gw; row < TG; row += ngw) {
        const int bl = row >> 12, s = row & 4095;
        { const u32x2 w = ldg<u32x2>(PML + (size_t)row * 512 + 4 * lane); const float f0 = bflo(w.x), f1 = bfhi(w.x), f2 = bflo(w.y), f3 = bfhi(w.y);
          const float rs = rsqrtf(wave_sum(f0 * f0 + f1 * f1 + f2 * f2 + f3 * f3) * (1.f / 256.f) + 1e-6f);
          u32x2 o; o.x = cvt_pk_bf16(f0 * rs * qg.x, f1 * rs * qg.y); o.y = cvt_pk_bf16(f2 * rs * qg.z, f3 * rs * qg.w); stg<u32x2>(CQN + (size_t)row * 256 + 4 * lane, o); }
        { const unsigned w = ldg<unsigned>(PML + (size_t)row * 512 + 256 + 2 * lane); const float f0 = bflo(w), f1 = bfhi(w);
          const float rs = rsqrtf(wave_sum(f0 * f0 + f1 * f1) * (1.f / 128.f) + 1e-6f);
          stg<unsigned>(CKVN + (size_t)row * 128 + 2 * lane, cvt_pk_bf16(f0 * rs * kg.x, f1 * rs * kg.y)); }
        if (lane < 16) { const float x1 = bf2f(PML[(size_t)row * 512 + 384 + lane]), x2 = bf2f(PML[(size_t)row * 512 + 400 + lane]);
          const f32x2 cs = rt[((size_t)(grp * GB + bl) * S + s) * 16 + lane];
          const unsigned o = cvt_pk_bf16(x1 * cs.x - x2 * cs.y, x1 * cs.y + x2 * cs.x);
#pragma unroll
          for (int hd = 0; hd < 8; ++hd) stg<unsigned>(KM + ((size_t)(bl * 8 + hd) * S + s) * 96 + 64 + 2 * lane, o); }
        { const u32x2 wc = ldg<u32x2>(PRW + (size_t)row * RW_COLS + 1536 + 4 * lane); u32x2 wp; wp.x = 0u; wp.y = 0u;
          if (s > 0) wp = ldg<u32x2>(PRW + (size_t)(row - 1) * RW_COLS + 1536 + 4 * lane);
          float c[4] = {bflo(wc.x), bfhi(wc.x), bflo(wc.y), bfhi(wc.y)}; const float p[4] = {bflo(wp.x), bfhi(wp.x), bflo(wp.y), bfhi(wp.y)}; const float m4[4] = {mu4.x, mu4.y, mu4.z, mu4.w};
#pragma unroll
          for (int j = 0; j < 4; ++j) { float v = c[j] + (p[j] - c[j]) * m4[j]; if (lane < 16) v = tanhf(v); else if (lane >= 32) v = sigmoidf_(v); c[j] = v; }
          u32x2 o; o.x = cvt_pk_bf16(c[0], c[1]); o.y = cvt_pk_bf16(c[2], c[3]); stg<u32x2>(LIN + (size_t)row * 256 + 4 * lane, o); }
    }
}

__device__ __forceinline__ void conv_phase(const AP a, int l) {
    const bf16_t* U = (const bf16_t*)(a.ws() + WS_U); bf16_t* ACT = (bf16_t*)(a.ws() + WS_ACT);
    const float* cw = (const float*)a.in(I_CW) + (size_t)l * 3 * 5632; const float* cb = (const float*)a.in(I_CB) + (size_t)l * 5632;
    const int gt = bid_opaque() * NTHREADS + tid_opaque(), ngt = gridDim.x * NTHREADS;
    constexpr int SEG = 16, NSEG = TG / SEG;
#pragma unroll 1
    for (int i = gt; i < NSEG * 352; i += ngt) {
        const int seg = i / 352, c0 = (i - seg * 352) * 8, row0 = seg * SEG, s0 = row0 & 4095;
        float wg[3][8], wv[3][8], bg[8], bv[8];
#pragma unroll
        for (int tp = 0; tp < 3; ++tp) { const f32x4 a0 = ldg<f32x4>(cw + tp * 5632 + c0), a1 = ldg<f32x4>(cw + tp * 5632 + c0 + 4), b0 = ldg<f32x4>(cw + tp * 5632 + DFF + c0), b1 = ldg<f32x4>(cw + tp * 5632 + DFF + c0 + 4);
            wg[tp][0] = a0.x; wg[tp][1] = a0.y; wg[tp][2] = a0.z; wg[tp][3] = a0.w; wg[tp][4] = a1.x; wg[tp][5] = a1.y; wg[tp][6] = a1.z; wg[tp][7] = a1.w;
            wv[tp][0] = b0.x; wv[tp][1] = b0.y; wv[tp][2] = b0.z; wv[tp][3] = b0.w; wv[tp][4] = b1.x; wv[tp][5] = b1.y; wv[tp][6] = b1.z; wv[tp][7] = b1.w; }
        { const f32x4 a0 = ldg<f32x4>(cb + c0), a1 = ldg<f32x4>(cb + c0 + 4), b0 = ldg<f32x4>(cb + DFF + c0), b1 = ldg<f32x4>(cb + DFF + c0 + 4);
            bg[0] = a0.x; bg[1] = a0.y; bg[2] = a0.z; bg[3] = a0.w; bg[4] = a1.x; bg[5] = a1.y; bg[6] = a1.z; bg[7] = a1.w; bv[0] = b0.x; bv[1] = b0.y; bv[2] = b0.z; bv[3] = b0.w; bv[4] = b1.x; bv[5] = b1.y; bv[6] = b1.z; bv[7] = b1.w; }
        float g2[8], v2[8], g1[8], v1[8];
        if (s0 >= 2) { load8(U + (size_t)(row0 - 2) * 5632 + c0, g2); load8(U + (size_t)(row0 - 2) * 5632 + DFF + c0, v2); load8(U + (size_t)(row0 - 1) * 5632 + c0, g1); load8(U + (size_t)(row0 - 1) * 5632 + DFF + c0, v1); }
        else {
#pragma unroll
            for (int j = 0; j < 8; ++j) { g2[j] = 0.f; v2[j] = 0.f; g1[j] = 0.f; v1[j] = 0.f; } }
#pragma unroll 8
        for (int r = 0; r < SEG; ++r) {
            float g0[8], v0[8], o[8]; const bf16_t* up = U + (size_t)(row0 + r) * 5632 + c0; load8(up, g0); load8(up + DFF, v0);
#pragma unroll
            for (int j = 0; j < 8; ++j) { const float cg_ = bg[j] + wg[0][j] * g2[j] + wg[1][j] * g1[j] + wg[2][j] * g0[j], cv_ = bv[j] + wv[0][j] * v2[j] + wv[1][j] * v1[j] + wv[2][j] * v0[j];
                o[j] = cg_ * sigmoidf_(cg_) * cv_; g2[j] = g1[j]; v2[j] = v1[j]; g1[j] = g0[j]; v1[j] = v0[j]; }
            store8(ACT + (size_t)(row0 + r) * DFF + c0, o);
        }
    }
}

#define MFMA32(a, b, c) __builtin_amdgcn_mfma_f32_32x32x16_bf16((a), (b), (c), 0, 0, 0)
__device__ __forceinline__ int pi32(int m) { return (m & ~12) | ((m & 4) << 1) | ((m & 8) >> 1); }
__device__ __forceinline__ float red8(float v) {
    v += __builtin_bit_cast(float, __builtin_amdgcn_update_dpp(0, __builtin_bit_cast(int, v), 0xB1, 0xF, 0xF, true));
    v += __builtin_bit_cast(float, __builtin_amdgcn_update_dpp(0, __builtin_bit_cast(int, v), 0x4E, 0xF, 0xF, true));
    v += __builtin_bit_cast(float, __builtin_amdgcn_update_dpp(0, __builtin_bit_cast(int, v), 0x141, 0xF, 0xF, true));
    return v;
}
__device__ __forceinline__ float fexp2(float x) { return __builtin_amdgcn_exp2f(x); }
__device__ __forceinline__ float xhalf_max(float v) {
    const unsigned u = __builtin_bit_cast(unsigned, v);
    const auto r = __builtin_amdgcn_permlane32_swap(u, u, false, false);
    return fmaxf(__builtin_bit_cast(float, (unsigned)r[0]), __builtin_bit_cast(float, (unsigned)r[1]));
}
__device__ __forceinline__ bf16x8 pack8(const f32x16& p, int s) {
    u32x4 w; w.x = cvt_pk_bf16(p[8 * s + 0], p[8 * s + 1]); w.y = cvt_pk_bf16(p[8 * s + 2], p[8 * s + 3]); w.z = cvt_pk_bf16(p[8 * s + 4], p[8 * s + 5]); w.w = cvt_pk_bf16(p[8 * s + 6], p[8 * s + 7]);
    return __builtin_bit_cast(bf16x8, w);
}
constexpr float NEG_BIG = -1e30f;
constexpr float RESCALE_THR = 8.f;

__device__ __forceinline__ void mla_unit(LAS unsigned char* lds, const AP a, int bl, int hd, int qb) {
    const int tid = tid_opaque(), wave = tid >> 6, lane = tid & 63, n = lane & 31, g = lane >> 5;
    constexpr int KSTR = 104, VSTR = 72, KB_BYTES = 64 * KSTR * 2, VB_BYTES = 64 * VSTR * 2, BUF = KB_BYTES + VB_BYTES;
    const bf16_t* Qp = (const bf16_t*)(a.ws() + WS_QM) + (size_t)(bl * 8 + hd) * S * 96;
    const bf16_t* Kp = (const bf16_t*)(a.ws() + WS_KM) + (size_t)(bl * 8 + hd) * S * 96;
    const bf16_t* Vp = (const bf16_t*)(a.ws() + WS_VTM) + (size_t)(bl * 8 + hd) * 64 * S;
    const int q0 = qb * 512 + wave * 64;
    bf16x8 qa[6], qbf[6];
#pragma unroll
    for (int s = 0; s < 6; ++s) { qa[s] = ldg<bf16x8>(Qp + (size_t)(q0 + n) * 96 + 16 * s + 8 * g); qbf[s] = ldg<bf16x8>(Qp + (size_t)(q0 + 32 + n) * 96 + 16 * s + 8 * g); }
    f32x16 oa[2], ob[2];
#pragma unroll
    for (int i = 0; i < 2; ++i)
#pragma unroll
        for (int r = 0; r < 16; ++r) { oa[i][r] = 0.f; ob[i][r] = 0.f; }
    float ma = NEG_BIG, la = 0.f, mb = NEG_BIG, lb = 0.f;
    const int ntiles = (qb + 1) * 8;
    const int kr_a = tid / 12, kc_a = tid - kr_a * 12, kr_b = (tid + 512) / 12, kc_b = (tid + 512) - kr_b * 12; const bool has_b = tid < 256;
    const int vr_ = tid >> 3, vc_ = tid & 7;
    const unsigned kofs_a = (kr_a * KSTR + kc_a * 8) * 2, kofs_b = (kr_b * KSTR + kc_b * 8) * 2, vofs = KB_BYTES + (vr_ * VSTR + vc_ * 8) * 2;
    u32x4 ka, kb_ = {0u, 0u, 0u, 0u}, vv;
#define MLA_GLOAD(k0) do { ka = ldg<u32x4>(Kp + (size_t)((k0) + kr_a) * 96 + kc_a * 8); if (has_b) kb_ = ldg<u32x4>(Kp + (size_t)((k0) + kr_b) * 96 + kc_b * 8); \
        vv = ldg<u32x4>(Vp + (size_t)vr_ * S + (k0) + vc_ * 8); } while (0)
#define MLA_LSTORE(buf) do { LAS unsigned char* b_ = lds + (buf) * BUF; *(LAS u32x4*)(b_ + kofs_a) = ka; if (has_b) *(LAS u32x4*)(b_ + kofs_b) = kb_; *(LAS u32x4*)(b_ + vofs) = vv; } while (0)
#define MLA_SOFTMAX(S0, BASE, M_, L_, O_, QR) do { \
        if (kbase + 31 > (QR)) { const int rel = (QR) + n - kbase - 8 * g; asm volatile("" ::: "memory"); \
            _Pragma("unroll") for (int r = 0; r < 16; ++r) { if (16 * (r >> 3) + (r & 7) > rel) S0[r] = NEG_BIG; } } \
        float mx = S0[0]; \
        _Pragma("unroll") for (int r = 1; r < 16; ++r) mx = fmaxf(mx, S0[r]); \
        mx = xhalf_max(mx); \
        const float mn = fmaxf(M_, (BASE) + mx); \
        if (__builtin_amdgcn_ballot_w64(mn > M_ + RESCALE_THR) != 0ull) { const float alpha = fexp2(M_ - mn), sh = mn - (BASE); M_ = mn; L_ *= alpha; \
            _Pragma("unroll") for (int i = 0; i < 2; ++i) _Pragma("unroll") for (int r = 0; r < 16; ++r) O_[i][r] *= alpha; \
            _Pragma("unroll") for (int r = 0; r < 16; ++r) S0[r] -= sh; } \
        float ls = 0.f; \
        _Pragma("unroll") for (int r = 0; r < 16; ++r) { S0[r] = fexp2(S0[r]); ls += S0[r]; } \
        L_ += ls; } while (0)
    MLA_GLOAD(0); MLA_LSTORE(0);
    __syncthreads();
    const unsigned krd = (pi32(n) * KSTR + 8 * g) * 2, vrd = KB_BYTES + (n * VSTR + 8 * g) * 2;
#pragma unroll 1
    for (int kt = 0; kt < ntiles; ++kt) {
        if (kt + 1 < ntiles) MLA_GLOAD(kt * 64 + 64);
        {
        const int k0 = kt * 64;
        LAS unsigned char* bb = lds + (kt & 1) * BUF; LAS unsigned char* bv = bb;
#pragma unroll
        for (int kb = 0; kb < 2; ++kb) {
        const int kbase = k0 + kb * 32;
        if (kbase <= q0 + 63) {
            const float basea = (ma > -1e29f) ? ma : 0.f, baseb = (mb > -1e29f) ? mb : 0.f;
            f32x16 a0, b0;
#pragma unroll
            for (int r = 0; r < 16; ++r) { a0[r] = -basea; b0[r] = -baseb; }
            {
            bf16x8 kfr[6];
#pragma unroll
            for (int s = 0; s < 6; ++s) kfr[s] = *(const LAS bf16x8*)(bb + krd + (kb * 32 * KSTR + 16 * s) * 2);
            __builtin_amdgcn_s_setprio(1);
#pragma unroll
            for (int s = 0; s < 6; ++s) a0 = MFMA32(kfr[s], qa[s], a0);
#pragma unroll
            for (int s = 0; s < 6; ++s) b0 = MFMA32(kfr[s], qbf[s], b0);
            __builtin_amdgcn_s_setprio(0);
            }
            MLA_SOFTMAX(a0, basea, ma, la, oa, q0);
            const bf16x8 pa0 = pack8(a0, 0), pa1 = pack8(a0, 1);
            MLA_SOFTMAX(b0, baseb, mb, lb, ob, q0 + 32);
            const bf16x8 pb0 = pack8(b0, 0), pb1 = pack8(b0, 1);
#pragma unroll
            for (int dvb = 0; dvb < 2; ++dvb) {
                const bf16x8 v0 = *(const LAS bf16x8*)(bv + vrd + (dvb * 32 * VSTR + kb * 32) * 2);
                const bf16x8 v1 = *(const LAS bf16x8*)(bv + vrd + (dvb * 32 * VSTR + kb * 32 + 16) * 2);
                __builtin_amdgcn_s_setprio(1);
                oa[dvb] = MFMA32(v0, pa0, oa[dvb]); ob[dvb] = MFMA32(v0, pb0, ob[dvb]); oa[dvb] = MFMA32(v1, pa1, oa[dvb]); ob[dvb] = MFMA32(v1, pb1, ob[dvb]);
                __builtin_amdgcn_s_setprio(0);
            }
        }
        }
        }
        if (kt + 1 < ntiles) MLA_LSTORE((kt + 1) & 1);
        __syncthreads();
    }
#undef MLA_GLOAD
#undef MLA_LSTORE
#undef MLA_SOFTMAX
    la += __shfl_xor(la, 32); lb += __shfl_xor(lb, 32);
    const float ila = 1.f / la, ilb = 1.f / lb;
    bf16_t* op = (bf16_t*)(a.ws() + WS_OML) + (size_t)(bl * S + q0 + n) * 512 + hd * 64 + 4 * g;
#pragma unroll
    for (int dvb = 0; dvb < 2; ++dvb)
#pragma unroll
        for (int c = 0; c < 4; ++c) { u32x2 w; w.x = cvt_pk_bf16(oa[dvb][4 * c] * ila, oa[dvb][4 * c + 1] * ila); w.y = cvt_pk_bf16(oa[dvb][4 * c + 2] * ila, oa[dvb][4 * c + 3] * ila);
            stg<u32x2>(op + dvb * 32 + 8 * c, w);
            u32x2 w2; w2.x = cvt_pk_bf16(ob[dvb][4 * c] * ilb, ob[dvb][4 * c + 1] * ilb); w2.y = cvt_pk_bf16(ob[dvb][4 * c + 2] * ilb, ob[dvb][4 * c + 3] * ilb);
            stg<u32x2>(op + (size_t)32 * 512 + dvb * 32 + 8 * c, w2); }
}

__device__ __forceinline__ int t5_bucket(int n) {
    if (n < 16) return n;
    const float nf = (float)n; int large = 16 + (int)(logf(nf / 16.f) / 2.0794415416798357f * 16.f);
    return large < 31 ? large : 31;
}
__device__ __forceinline__ void diff_unit(LAS unsigned char* lds, const AP a, int l, int grp, int bl, int hd, int qb) {
    const int tid = tid_opaque(), wave = tid >> 6, lane = tid & 63, n = lane & 31, g = lane >> 5, map = wave >> 2, qs = wave & 3;
    constexpr int KSTR = 136, VSTR = 72, KB_BYTES = 64 * KSTR * 2, VB_BYTES = 128 * VSTR * 2, BUF = KB_BYTES + VB_BYTES;
    constexpr int OFF_POS = 3 * BUF, OFF_LUT = OFF_POS + (3 * 64 + 4) * 4;
    constexpr int XSTR = 132;
    const bf16_t* QK = (const bf16_t*)(a.ws() + WS_QKD) + (size_t)bl * S * 1024;
    const bf16_t* Vp = (const bf16_t*)(a.ws() + WS_VTD) + (size_t)(bl * 4 + hd) * 128 * S;
    const int* pos = (const int*)a.in(I_POS) + (size_t)(grp * GB + bl) * S;
    const int q0 = qb * 128 + qs * 32;
    LAS float* lut = (LAS float*)(lds + OFF_LUT); LAS int* posk = (LAS int*)(lds + OFF_POS);
    if (tid < 129) lut[tid] = ((const float*)a.in(I_RELB))[t5_bucket(tid) * 4 + hd] * LOG2E;
    bf16x8 qf[4];
#pragma unroll
    for (int s = 0; s < 4; ++s) qf[s] = ldg<bf16x8>(QK + (size_t)(q0 + n) * 1024 + hd * 128 + map * 64 + 16 * s + 8 * g);
    const int posq = pos[q0 + n];
    int qmin = posq;
#pragma unroll
    for (int of = 1; of < 32; of <<= 1) qmin = min(qmin, __shfl_xor(qmin, of));
    f32x16 o[4];
#pragma unroll
    for (int i = 0; i < 4; ++i)
#pragma unroll
        for (int r = 0; r < 16; ++r) o[i][r] = 0.f;
    float m = NEG_BIG, lsum = 0.f;
    const int ntiles = (qb + 1) * 2;
    const int kr0 = tid >> 4, kc0 = tid & 15, kr1 = kr0 + 32;
    const int vr0 = tid >> 3, vc0 = tid & 7, vr1 = vr0 + 64;
    const unsigned kofs0 = (kr0 * KSTR + kc0 * 8) * 2, kofs1 = (kr1 * KSTR + kc0 * 8) * 2, vofs0 = KB_BYTES + (vr0 * VSTR + vc0 * 8) * 2, vofs1 = KB_BYTES + (vr1 * VSTR + vc0 * 8) * 2;
    u32x4 k0r, k1r, v0r, v1r; int pkr = 0;
#define DF_GLOAD(k0) do { k0r = ldg<u32x4>(QK + (size_t)((k0) + kr0) * 1024 + 512 + hd * 128 + kc0 * 8); k1r = ldg<u32x4>(QK + (size_t)((k0) + kr1) * 1024 + 512 + hd * 128 + kc0 * 8); \
        v0r = ldg<u32x4>(Vp + (size_t)vr0 * S + (k0) + vc0 * 8); v1r = ldg<u32x4>(Vp + (size_t)vr1 * S + (k0) + vc0 * 8); if (tid < 64) pkr = pos[(k0) + tid]; } while (0)
#define DF_LSTORE(buf) do { LAS unsigned char* b_ = lds + (buf) * BUF; *(LAS u32x4*)(b_ + kofs0) = k0r; *(LAS u32x4*)(b_ + kofs1) = k1r; *(LAS u32x4*)(b_ + vofs0) = v0r; *(LAS u32x4*)(b_ + vofs1) = v1r; \
        if (tid < 64) { posk[(buf) * 64 + tid] = pkr; int km_ = pkr; _Pragma("unroll") for (int of = 1; of < 64; of <<= 1) km_ = max(km_, __shfl_xor(km_, of)); if (tid == 0) posk[192 + (buf)] = km_; } } while (0)
    DF_GLOAD(0); DF_LSTORE(0);
    DF_GLOAD(64); DF_LSTORE(1);
    __syncthreads();
    const float lutfar = lut[128];
    const unsigned krd = (pi32(n) * KSTR + map * 64 + 8 * g) * 2, vrd = KB_BYTES + (n * VSTR + 8 * g) * 2;
#define DF_QK(BUFP, ST0, ST1, BASE, ACT1, FAR) do { BASE = (m > -1e29f) ? m : 0.f; const float ci_ = ((FAR) ? lutfar : 0.f) - BASE; \
        _Pragma("unroll") for (int r = 0; r < 16; ++r) { ST0[r] = ci_; ST1[r] = (ACT1) ? ci_ : NEG_BIG; } \
        __builtin_amdgcn_s_setprio(1); \
        _Pragma("unroll") for (int s_ = 0; s_ < 4; ++s_) { const bf16x8 kf = *(const LAS bf16x8*)((BUFP) + krd + (16 * s_) * 2); ST0 = MFMA32(kf, qf[s_], ST0); } \
        if (ACT1) { _Pragma("unroll") for (int s_ = 0; s_ < 4; ++s_) { const bf16x8 kf = *(const LAS bf16x8*)((BUFP) + krd + (32 * KSTR + 16 * s_) * 2); ST1 = MFMA32(kf, qf[s_], ST1); } } __builtin_amdgcn_s_setprio(0); } while (0)
    f32x16 st0, st1, sn0, sn1; float basec = 0.f, basen = 0.f; bool a1c = (32 <= q0 + 31), a1n = false, farc = (qmin - posk[192] >= 128), farn = false;
#pragma unroll
    for (int r = 0; r < 16; ++r) { sn0[r] = 0.f; sn1[r] = 0.f; }
    DF_QK(lds, st0, st1, basec, a1c, farc);
    int bcur = 0;
#pragma unroll 1
    for (int kt = 0; kt < ntiles; ++kt) {
        const int k0 = kt * 64; const int bnx = (bcur == 2) ? 0 : bcur + 1, bn2 = (bnx == 2) ? 0 : bnx + 1;
        if (kt + 2 < ntiles) DF_GLOAD(k0 + 128);
        LAS unsigned char* bb = lds + bcur * BUF; const LAS int* pk = posk + bcur * 64;
        if (kt + 1 < ntiles && k0 + 64 <= q0 + 31) { farn = (qmin - posk[192 + bnx] >= 128); a1n = (k0 + 96 <= q0 + 31); DF_QK(lds + bnx * BUF, sn0, sn1, basen, a1n, farn); }
        if (k0 <= q0 + 31) {
            if (!farc) { asm volatile("" ::: "memory");
#pragma unroll
                for (int r = 0; r < 16; ++r) { int d0 = posq - pk[16 * (r >> 3) + 8 * g + (r & 7)]; d0 = d0 < 0 ? 0 : (d0 > 128 ? 128 : d0); st0[r] += lut[d0];
                    int d1 = posq - pk[32 + 16 * (r >> 3) + 8 * g + (r & 7)]; d1 = d1 < 0 ? 0 : (d1 > 128 ? 128 : d1); st1[r] += lut[d1]; }
            }
            if (k0 + 63 > q0) { const int rel = q0 + n - k0 - 8 * g; asm volatile("" ::: "memory");
#pragma unroll
                for (int r = 0; r < 16; ++r) { if (16 * (r >> 3) + (r & 7) > rel) st0[r] = NEG_BIG; if (32 + 16 * (r >> 3) + (r & 7) > rel) st1[r] = NEG_BIG; } }
            float mx = fmaxf(st0[0], st1[0]);
#pragma unroll
            for (int r = 1; r < 16; ++r) mx = fmaxf(mx, fmaxf(st0[r], st1[r]));
            mx = xhalf_max(mx);
            const float mn = fmaxf(m, basec + mx);
            if (__builtin_amdgcn_ballot_w64(mn > m + RESCALE_THR) != 0ull) {
                const float alpha = fexp2(m - mn); m = mn; lsum *= alpha;
#pragma unroll
                for (int i = 0; i < 4; ++i)
#pragma unroll
                    for (int r = 0; r < 16; ++r) o[i][r] *= alpha;
            }
            const float sh = m - basec;
            if (__builtin_amdgcn_ballot_w64(sh != 0.f) != 0ull) {
#pragma unroll
                for (int r = 0; r < 16; ++r) { st0[r] -= sh; st1[r] -= sh; }
            }
            float ls = 0.f;
#pragma unroll
            for (int r = 0; r < 16; ++r) { st0[r] = fexp2(st0[r]); st1[r] = fexp2(st1[r]); ls += st0[r] + st1[r]; }
            lsum += ls;
            const bf16x8 p0 = pack8(st0, 0), p1 = pack8(st0, 1), p2 = pack8(st1, 0), p3 = pack8(st1, 1);
#pragma unroll
            for (int dvb = 0; dvb < 4; ++dvb) {
                const bf16x8 v0 = *(const LAS bf16x8*)(bb + vrd + (dvb * 32 * VSTR) * 2);
                const bf16x8 v1 = *(const LAS bf16x8*)(bb + vrd + (dvb * 32 * VSTR + 16) * 2);
                __builtin_amdgcn_s_setprio(1);
                o[dvb] = MFMA32(v0, p0, o[dvb]); o[dvb] = MFMA32(v1, p1, o[dvb]);
                if (a1c) {
                    const bf16x8 v2 = *(const LAS bf16x8*)(bb + vrd + (dvb * 32 * VSTR + 32) * 2);
                    const bf16x8 v3 = *(const LAS bf16x8*)(bb + vrd + (dvb * 32 * VSTR + 48) * 2);
                    o[dvb] = MFMA32(v2, p2, o[dvb]); o[dvb] = MFMA32(v3, p3, o[dvb]); }
                __builtin_amdgcn_s_setprio(0);
            }
        }
        if (kt + 2 < ntiles) DF_LSTORE(bn2);
        __syncthreads();
        st0 = sn0; st1 = sn1; basec = basen; a1c = a1n; farc = farn; bcur = bnx;
    }
#undef DF_QK
#undef DF_GLOAD
#undef DF_LSTORE
    lsum += __shfl_xor(lsum, 32);
    const float* lam = (const float*)a.in(I_LAM) + l * 256;
    const float d01 = wave_sum(lam[lane] * lam[64 + lane]), d23 = wave_sum(lam[128 + lane] * lam[192 + lane]);
    int lo_ = l; asm volatile("" : "+s"(lo_));
    const float lam_init = (lo_ == 0) ? 0.2f : (0.8f - 0.6f * 0.7408182206817179f);
    const float lam_full = __expf(d01) - __expf(d23) + lam_init;
    LAS float* xch = (LAS float*)lds + (qs * 32 + n) * XSTR;
    if (map == 1) { const float sc = lam_full / lsum;
#pragma unroll
        for (int dvb = 0; dvb < 4; ++dvb)
#pragma unroll
            for (int c = 0; c < 4; ++c) { f32x4 w; w.x = o[dvb][4 * c] * sc; w.y = o[dvb][4 * c + 1] * sc; w.z = o[dvb][4 * c + 2] * sc; w.w = o[dvb][4 * c + 3] * sc;
                *(LAS f32x4*)(xch + dvb * 32 + 8 * c + 4 * g) = w; } }
    __syncthreads();
    if (map == 0) { const float il = 1.f / lsum; float ss = 0.f;
#pragma unroll
        for (int dvb = 0; dvb < 4; ++dvb)
#pragma unroll
            for (int c = 0; c < 4; ++c) { const f32x4 w = *(const LAS f32x4*)(xch + dvb * 32 + 8 * c + 4 * g);
                o[dvb][4 * c] = o[dvb][4 * c] * il - w.x; o[dvb][4 * c + 1] = o[dvb][4 * c + 1] * il - w.y; o[dvb][4 * c + 2] = o[dvb][4 * c + 2] * il - w.z; o[dvb][4 * c + 3] = o[dvb][4 * c + 3] * il - w.w;
                ss += o[dvb][4 * c] * o[dvb][4 * c] + o[dvb][4 * c + 1] * o[dvb][4 * c + 1] + o[dvb][4 * c + 2] * o[dvb][4 * c + 2] + o[dvb][4 * c + 3] * o[dvb][4 * c + 3]; }
        ss += __shfl_xor(ss, 32);
        const float rs = rsqrtf(ss * (1.f / 128.f) + 1e-5f) * (1.f - lam_init);
        const float* sub = (const float*)a.in(I_SUBLN) + l * 128;
        bf16_t* op = (bf16_t*)(a.ws() + WS_ODF) + (size_t)(bl * S + q0 + n) * 512 + hd * 128 + 4 * g;
#pragma unroll
        for (int dvb = 0; dvb < 4; ++dvb)
#pragma unroll
            for (int c = 0; c < 4; ++c) { const f32x4 sg = ldg<f32x4>(sub + dvb * 32 + 8 * c + 4 * g);
                u32x2 w; w.x = cvt_pk_bf16(o[dvb][4 * c] * rs * sg.x, o[dvb][4 * c + 1] * rs * sg.y); w.y = cvt_pk_bf16(o[dvb][4 * c + 2] * rs * sg.z, o[dvb][4 * c + 3] * rs * sg.w);
                stg<u32x2>(op + dvb * 32 + 8 * c, w); } }
    __syncthreads();
}

__device__ __forceinline__ float red16(float v) {
    v += __builtin_bit_cast(float, __builtin_amdgcn_update_dpp(0, __builtin_bit_cast(int, v), 0xB1, 0xF, 0xF, true));
    v += __builtin_bit_cast(float, __builtin_amdgcn_update_dpp(0, __builtin_bit_cast(int, v), 0x4E, 0xF, 0xF, true));
    v += __builtin_bit_cast(float, __builtin_amdgcn_update_dpp(0, __builtin_bit_cast(int, v), 0x141, 0xF, 0xF, true));
    v += __builtin_bit_cast(float, __builtin_amdgcn_update_dpp(0, __builtin_bit_cast(int, v), 0x140, 0xF, 0xF, true));
    return v;
}
__device__ __forceinline__ void scan_job(LAS unsigned char* lds, const AP a, int l, int bl, int hd, int rh) {
    const int tid = tid_opaque();
    constexpr int CH = 16, VSZ = CH * 64, BUFSZ = 6 * VSZ, YSTR = 34, YBUF = CH * 16 * YSTR;
    LAS float* vec = (LAS float*)lds; LAS float* Yp = vec + 2 * BUFSZ;
    const bf16_t* PRW = (const bf16_t*)(a.ws() + WS_PRW) + (size_t)bl * S * RW_COLS; const bf16_t* WAG = (const bf16_t*)(a.ws() + WS_WAG) + (size_t)bl * S * 1536;
    float* Yg = (float*)(a.ws() + WS_Y) + (size_t)bl * S * 512 + hd * 64 + rh * 32; float* RKB = (float*)(a.ws() + WS_RKB) + (size_t)bl * S * 8 + hd;
    const bool producer = tid >= 256;
    const int ptid = tid & 255, tt = ptid >> 4, jq = ptid & 15, c0 = hd * 64 + jq * 4;
    float mur[4], muk[4], muv[4], kkp[4], kap[4], rkp[4];
    if (producer) { const float* mu = (const float*)a.in(I_MU) + l * RW_COLS;
#pragma unroll
      for (int j = 0; j < 4; ++j) { mur[j] = ldg<float>(mu + c0 + j); muk[j] = ldg<float>(mu + 512 + c0 + j); muv[j] = ldg<float>(mu + 1024 + c0 + j); kkp[j] = ldg<float>((const float*)a.in(I_KK) + l * 512 + c0 + j);
          kap[j] = ldg<float>((const float*)a.in(I_KA) + l * 512 + c0 + j); rkp[j] = ldg<float>((const float*)a.in(I_RK) + l * 512 + c0 + j); } }
    else {
#pragma unroll
      for (int j = 0; j < 4; ++j) { mur[j] = 0.f; muk[j] = 0.f; muv[j] = 0.f; kkp[j] = 0.f; kap[j] = 0.f; rkp[j] = 0.f; } }
    f32x2 sA0 = {0.f, 0.f}, sA1 = {0.f, 0.f}, sB0 = {0.f, 0.f}, sB1 = {0.f, 0.f};
    const int srow = tt;
#define SCAN_LD4(p_, v_) do { const u32x2 w_ = ldg<u32x2>(p_); v_[0] = bflo(w_.x); v_[1] = bfhi(w_.x); v_[2] = bflo(w_.y); v_[3] = bfhi(w_.y); } while (0)
#define SCAN_PROLOGUE(chn) do { const int t = (chn) * CH + tt; LAS float* bp = vec + ((chn) & 1) * BUFSZ; \
          float r[4], k[4], v[4], pr[4], pk[4], pv[4], e[4], aa[4]; \
          const bf16_t* p = PRW + (size_t)t * RW_COLS + c0; SCAN_LD4(p, r); SCAN_LD4(p + 512, k); SCAN_LD4(p + 1024, v); \
          if (t > 0) { SCAN_LD4(p - RW_COLS, pr); SCAN_LD4(p - RW_COLS + 512, pk); SCAN_LD4(p - RW_COLS + 1024, pv); } \
          else { _Pragma("unroll") for (int j = 0; j < 4; ++j) { pr[j] = 0.f; pk[j] = 0.f; pv[j] = 0.f; } } \
          SCAN_LD4(WAG + (size_t)t * 1536 + c0, e); SCAN_LD4(WAG + (size_t)t * 1536 + 512 + c0, aa); \
          float ss = 0.f, rk = 0.f, kk[4]; \
          _Pragma("unroll") for (int j = 0; j < 4; ++j) { r[j] += (pr[j] - r[j]) * mur[j]; k[j] += (pk[j] - k[j]) * muk[j]; v[j] += (pv[j] - v[j]) * muv[j]; kk[j] = k[j] * kkp[j]; ss += kk[j] * kk[j]; } \
          ss = red16(ss); const float inv = 1.f / fmaxf(sqrtf(ss), 1e-12f); \
          _Pragma("unroll") for (int j = 0; j < 4; ++j) { kk[j] *= inv; k[j] = k[j] * (1.f + (aa[j] - 1.f) * kap[j]); rk += r[j] * k[j] * rkp[j]; e[j] = __expf(-e[j]); aa[j] = kk[j] * aa[j]; } \
          rk = red16(rk); \
          const int o = tt * 64 + jq * 4; \
          *(LAS f32x4*)(bp + o) = (f32x4){r[0], r[1], r[2], r[3]}; *(LAS f32x4*)(bp + VSZ + o) = (f32x4){e[0], e[1], e[2], e[3]}; *(LAS f32x4*)(bp + 2 * VSZ + o) = (f32x4){k[0], k[1], k[2], k[3]}; \
          *(LAS f32x4*)(bp + 3 * VSZ + o) = (f32x4){v[0], v[1], v[2], v[3]}; *(LAS f32x4*)(bp + 4 * VSZ + o) = (f32x4){kk[0], kk[1], kk[2], kk[3]}; *(LAS f32x4*)(bp + 5 * VSZ + o) = (f32x4){aa[0], aa[1], aa[2], aa[3]}; \
          if (rh == 0 && jq == 0) stg<float>(RKB + (size_t)t * 8, rk); } while (0)
#define SCAN_FLUSH(chn) do { const LAS float* yp = Yp + ((chn) & 1) * YBUF + tt * 16 * YSTR + 2 * jq; f32x2 acc_ = {0.f, 0.f}; \
          _Pragma("unroll") for (int q_ = 0; q_ < 16; ++q_) { const f32x2 x_ = *(const LAS f32x2*)(yp + q_ * YSTR); acc_.x += x_.x; acc_.y += x_.y; } \
          stg<f32x2>(Yg + (size_t)((chn) * CH + tt) * 512 + 2 * jq, acc_); } while (0)
    if (producer) SCAN_PROLOGUE(0);
    __syncthreads();
    constexpr int NCH = S / CH;
#pragma unroll 1
    for (int ch = 0; ch < NCH; ++ch) {
        if (producer) {
            if (ch > 0) SCAN_FLUSH(ch - 1);
            if (ch + 1 < NCH) SCAN_PROLOGUE(ch + 1);
        } else {
            __builtin_amdgcn_s_setprio(3);
            const LAS float* bp = vec + (ch & 1) * BUFSZ; LAS float* yl = Yp + (ch & 1) * YBUF + jq * YSTR + 2 * srow;
            const int o0 = jq * 4, vo = 3 * VSZ + rh * 32 + 2 * srow;
            f32x4 rN = *(const LAS f32x4*)(bp + o0), wN = *(const LAS f32x4*)(bp + VSZ + o0), kN = *(const LAS f32x4*)(bp + 2 * VSZ + o0), kkN = *(const LAS f32x4*)(bp + 4 * VSZ + o0), bN = *(const LAS f32x4*)(bp + 5 * VSZ + o0);
            f32x2 vN = *(const LAS f32x2*)(bp + vo);
#pragma unroll 4
            for (int st = 0; st < CH; ++st) {
                const f32x4 w = wN, kk = kkN, b = bN, k = kN, r = rN; const f32x2 v = vN;
                const int on = ((st + 1) & (CH - 1)) * 64;
                rN = *(const LAS f32x4*)(bp + on + o0); wN = *(const LAS f32x4*)(bp + VSZ + on + o0); kN = *(const LAS f32x4*)(bp + 2 * VSZ + on + o0); kkN = *(const LAS f32x4*)(bp + 4 * VSZ + on + o0); bN = *(const LAS f32x4*)(bp + 5 * VSZ + on + o0);
                vN = *(const LAS f32x2*)(bp + on + vo);
                const f32x2 kk0 = {kk.x, kk.y}, kk1 = {kk.z, kk.w}, w0 = {w.x, w.y}, w1 = {w.z, w.w}, b0 = {b.x, b.y}, b1 = {b.z, b.w}, k0 = {k.x, k.y}, k1 = {k.z, k.w}, r0 = {r.x, r.y}, r1 = {r.z, r.w};
                const f32x2 va = {v.x, v.x}, vb = {v.y, v.y};
                const f32x2 pa = sA0 * kk0 + sA1 * kk1, pb = sB0 * kk0 + sB1 * kk1;
                const float saA = -red16(pa.x + pa.y), saB = -red16(pb.x + pb.y);
                const f32x2 sav = {saA, saA}, sbv = {saB, saB};
                sA0 = sA0 * w0 + (sav * b0 + va * k0); sA1 = sA1 * w1 + (sav * b1 + va * k1);
                sB0 = sB0 * w0 + (sbv * b0 + vb * k0); sB1 = sB1 * w1 + (sbv * b1 + vb * k1);
                const f32x2 ya = sA0 * r0 + sA1 * r1, yb = sB0 * r0 + sB1 * r1;
                *(LAS f32x2*)(yl + st * 16 * YSTR) = (f32x2){ya.x + ya.y, yb.x + yb.y};
            }
            __builtin_amdgcn_s_setprio(0);
        }
        __syncthreads();
    }
    if (producer) SCAN_FLUSH(NCH - 1);
#undef SCAN_PROLOGUE
#undef SCAN_FLUSH
#undef SCAN_LD4
    __syncthreads();
}

__device__ __forceinline__ void post_phase(const AP a, int l) {
    const float* Y = (const float*)(a.ws() + WS_Y); const float* RKB = (const float*)(a.ws() + WS_RKB);
    const bf16_t* PRW = (const bf16_t*)(a.ws() + WS_PRW); const bf16_t* WAG = (const bf16_t*)(a.ws() + WS_WAG); bf16_t* ORW = (bf16_t*)(a.ws() + WS_ORW);
    const int gt = bid_opaque() * NTHREADS + tid_opaque(), ngt = gridDim.x * NTHREADS;
    const int c0 = (gt & 63) * 8;
    float mu8[8], lw8[8], lb8[8];
    { const float* mu = (const float*)a.in(I_MU) + l * RW_COLS + 1024 + c0; const float* lnw = (const float*)a.in(I_LNW) + l * 512 + c0; const float* lnb = (const float*)a.in(I_LNB) + l * 512 + c0;
      const f32x4 m0 = ldg<f32x4>(mu), m1 = ldg<f32x4>(mu + 4), w0 = ldg<f32x4>(lnw), w1 = ldg<f32x4>(lnw + 4), b0 = ldg<f32x4>(lnb), b1 = ldg<f32x4>(lnb + 4);
      mu8[0] = m0.x; mu8[1] = m0.y; mu8[2] = m0.z; mu8[3] = m0.w; mu8[4] = m1.x; mu8[5] = m1.y; mu8[6] = m1.z; mu8[7] = m1.w;
      lw8[0] = w0.x; lw8[1] = w0.y; lw8[2] = w0.z; lw8[3] = w0.w; lw8[4] = w1.x; lw8[5] = w1.y; lw8[6] = w1.z; lw8[7] = w1.w;
      lb8[0] = b0.x; lb8[1] = b0.y; lb8[2] = b0.z; lb8[3] = b0.w; lb8[4] = b1.x; lb8[5] = b1.y; lb8[6] = b1.z; lb8[7] = b1.w; }
#pragma unroll 2
    for (int i = gt; i < TG * 64; i += ngt) {
        const int row = i >> 6, s = row & 4095;
        float y[8], v[8], pv[8], gg[8];
        { const f32x4 x0 = ldg<f32x4>(Y + (size_t)row * 512 + c0), x1 = ldg<f32x4>(Y + (size_t)row * 512 + c0 + 4); y[0] = x0.x; y[1] = x0.y; y[2] = x0.z; y[3] = x0.w; y[4] = x1.x; y[5] = x1.y; y[6] = x1.z; y[7] = x1.w; }
        load8(PRW + (size_t)row * RW_COLS + 1024 + c0, v);
        if (s > 0) load8(PRW + (size_t)(row - 1) * RW_COLS + 1024 + c0, pv);
        else {
#pragma unroll
            for (int j = 0; j < 8; ++j) pv[j] = 0.f; }
        load8(WAG + (size_t)row * 1536 + 1024 + c0, gg);
        const float rk = ldg<float>(RKB + (size_t)row * 8 + (c0 >> 6));
        float sm = 0.f;
#pragma unroll
        for (int j = 0; j < 8; ++j) sm += y[j];
        const float mean = red8(sm) * (1.f / 64.f); float sv = 0.f;
#pragma unroll
        for (int j = 0; j < 8; ++j) { y[j] -= mean; sv += y[j] * y[j]; }
        const float rs = rsqrtf(red8(sv) * (1.f / 64.f) + 64e-5f);
#pragma unroll
        for (int j = 0; j < 8; ++j) { const float vm = v[j] + (pv[j] - v[j]) * mu8[j]; y[j] = (y[j] * rs * lw8[j] + lb8[j] + rk * vm) * gg[j]; }
        store8(ORW + (size_t)row * 512 + c0, y);
    }
}

__device__ __forceinline__ void jobs_phase(LAS unsigned char* lds, const AP a, int l, int grp, int rep) {
    unsigned* ctr = (unsigned*)(a.ws() + WS_CTL) + (l * NGRP + grp) * 2 + rep;
    LAS int* jslot = (LAS int*)(lds + 150 * 1024);
    constexpr int NSCAN = GB * 8 * 2, NATT = 8 * 96, NGATE = (TG / 256) * 6, NJOBS = NSCAN + NATT + NGATE;
    for (;;) {
        if (tid_opaque() == 0) *jslot = (int)__hip_atomic_fetch_add(ctr, 1u, __ATOMIC_RELAXED, __HIP_MEMORY_SCOPE_AGENT);
        __syncthreads();
        int j = *jslot;
        __syncthreads();
#ifdef JOBSEL
        if (rep == 1) { if (JOBSEL == 1) { if (j >= NSCAN) break; } else j += NSCAN; }
#endif
        if (j >= NJOBS) break;
        if (j < NSCAN) scan_job(lds, a, l, j >> 4, (j >> 1) & 7, j & 1);
        else if (j >= NSCAN + NATT) {
            const int gq = j - NSCAN - NATT, pn = 15 + 2 * (gq / (TG / 256)), pm = gq % (TG / 256);
            Epi E; E.kind = K_P; E.aux = 0; E.grp = grp; E.pad = 0; E.ws = a.ws(); E.f0 = (const float*)a.in(I_BGATE) + l * GT_COLS; E.f1 = nullptr; E.xi = nullptr; E.xo = nullptr;
            run_gemm_unit(lds, (const bf16_t*)(a.ws() + WS_HB), 1024, (const bf16_t*)(a.ws() + WT_IN), TG, NP, 1024, E, pm, pn, 2);
            __syncthreads(); }
        else { const int q = j - NSCAN, d = q / 96, r = q - d * 96;
            if (r < 32) mla_unit(lds, a, r >> 3, r & 7, 7 - d);
            else { const int rr = r - 32; diff_unit(lds, a, l, grp, (rr & 15) >> 2, rr & 3, 31 - 4 * d - (rr >> 4)); } }
    }
}


constexpr int LDS_BYTES = 151 * 1024;
#ifndef REPEAT_MASK
#define REPEAT_MASK 0
#endif
constexpr int NSLOT = 12 + __builtin_popcount(REPEAT_MASK);
constexpr int NPHASE = 1 + DEPTH * NGRP * NSLOT + 1;
__global__ void __launch_bounds__(NTHREADS, 2) mega(Args a_unused) {
    extern __shared__ __attribute__((aligned(16))) unsigned char lds_raw[];
    LAS unsigned char* lds = (LAS unsigned char*)lds_raw;
    cg::grid_group grid = cg::this_grid();
    { const int tid = threadIdx.x; const unsigned* kp = (const unsigned*)__builtin_amdgcn_kernarg_segment_ptr();
      if (tid < (int)(sizeof(Args) / 4)) ((LAS unsigned*)(lds + ARGS_OFF))[tid] = kp[tid];
      if (tid == 0) { ((LAS unsigned*)(lds + 150 * 1024 + 16))[0] = 0u; ((LAS unsigned*)(lds + 150 * 1024 + 16))[1] = 0u; }
      __syncthreads(); }
    AP a; a.t = (const LAS unsigned long long*)(lds + ARGS_OFF);
    XcdBarrier xbar = xcd_barrier_post((unsigned*)(a.ws() + WS_CTL) + 4096, (volatile LAS unsigned*)(lds + 150 * 1024 + 16));
    const int plo = __builtin_amdgcn_readfirstlane(((const LAS int*)(lds + ARGS_OFF))[70]), phi = __builtin_amdgcn_readfirstlane(((const LAS int*)(lds + ARGS_OFF))[71]);
#pragma unroll 1
    for (int p = plo; p < phi; ++p) {
        unsigned char* ws = a.ws();
        if (p == plo + 1) grid.sync();
        else if (p > plo) xcd_barrier(xbar);
        const int tid = tid_opaque(), lane = tid & 63, wave = __builtin_amdgcn_readfirstlane(tid >> 6);
        const int gw = bid_opaque() * NWAVES + wave, ngw = gridDim.x * NWAVES;
        if (p == 0) { prologue_phase(a); continue; }
        if (p == NPHASE - 1) { rmsnorm_rows_f32(a.out(), (const float*)a.in(I_NFIN), NB * S, gw, ngw, lane); continue; }
                const int idx = p - 1, l = idx / (NGRP * NSLOT), rem = idx % (NGRP * NSLOT), grp = rem / NSLOT, sl = rem % NSLOT;
        int k = 0, rep = 0;
        { int s_ = 0;
          for (int q = 0; q < 12; ++q) { if (s_ == sl) { k = q; rep = 0; break; } ++s_; if ((REPEAT_MASK >> q) & 1) { if (s_ == sl) { k = q; rep = 1; break; } ++s_; } } }
        const float* xin = (l == 0) ? (const float*)a.in(I_X) : (const float*)a.out();
        int ng = 0;
        {
        switch (k) {
        case 0:
            if (grp == 0) wt_convert(a, l, (LAS float*)(lds + wave * 8448), gw, ngw, lane);
            rmsnorm_rows(xin + (size_t)grp * TG * D, (const float*)a.in(I_NMIX) + l * D, (bf16_t*)(ws + WS_HB), TG, gw, ngw, lane);
            break;
        case 2: c1_phase(a, l, grp, gw, ngw, lane); break;
        case 4: jobs_phase(lds, a, l, grp, rep); break;
        case 5: post_phase(a, l); break;
        case 8: rmsnorm_rows(a.out() + (size_t)grp * TG * D, (const float*)a.in(I_NFFN) + l * D, (bf16_t*)(ws + WS_HB), TG, gw, ngw, lane); break;
        case 10: conv_phase(a, l); break;
        case 3: ng = 3; break;
        default: ng = 1; break;
        }
#pragma unroll 1
        for (int gi = 0; gi < ng; ++gi) {
            Epi E; E.kind = K_UP; E.aux = gi; E.grp = grp; E.pad = 0; E.ws = ws; E.f0 = nullptr; E.f1 = nullptr; E.xi = nullptr; E.xo = nullptr;
            size_t aoff = WS_HB, boff = WT_UP, brA = 0, brB = 0; int lda = 1024, N = 5632, K = 1024, nbr = 1;
            switch (k) {
            case 1: E.kind = K_P; boff = WT_IN; N = 3840; break;
            case 3:
                if (gi == 0) { E.kind = K_Q; aoff = WS_CQN; lda = 256; boff = WT_UQ; N = 768; K = 256; }
                else if (gi == 1) { E.kind = K_KV; aoff = WS_CKVN; lda = 128; boff = WT_UKV; N = 1024; K = 128; }
                else { E.kind = K_LORA; E.f0 = (const float*)a.in(I_W0) + l * 512; E.f1 = (const float*)a.in(I_A0) + l * 512; aoff = WS_LIN; lda = 256; boff = WT_LORA; N = 1536; K = 256; }
                break;
            case 6: E.kind = K_BR3; aoff = WS_ORW; lda = 512; boff = WT_BR; N = 1024; K = 512; nbr = 3; brA = 16 * MiB; brB = (size_t)1024 * 512 * 2; break;
            case 7: E.kind = K_WO; E.xi = xin; E.xo = a.out(); boff = WT_O; N = 1024; break;
            case 9: break;
            default: E.kind = K_DN; E.xi = a.out(); E.xo = a.out(); aoff = WS_ACT; lda = DFF; boff = WT_DN; N = 1024; K = DFF; break;
            }
            run_gemm(lds, (const bf16_t*)(ws + aoff), lda, (const bf16_t*)(ws + boff), TG, N, K, E, nbr, brA, brB);
        }
        }
    }
}

#ifndef MK_MULTI
#define MK_MULTI 0
#endif
extern "C" void kernel_launch(void* const* d_in, const int* in_sizes, int n_in, void* d_out, int out_size, void* d_ws, size_t ws_size, hipStream_t stream) {
    static int grid = 0;
    if (grid == 0) {
        if (n_in != 33 || out_size != NB * S * D || ws_size < 512 * MiB) { fprintf(stderr, "kernel_launch: unexpected shapes (n_in %d, out %d, ws %zu)\n", n_in, out_size, ws_size); grid = -1; return; }
        int dev = 0, cus = 0, per_cu = 0;
        hipGetDevice(&dev); hipDeviceGetAttribute(&cus, hipDeviceAttributeMultiprocessorCount, dev);
        if (hipFuncSetAttribute((const void*)mega, hipFuncAttributeMaxDynamicSharedMemorySize, LDS_BYTES) != hipSuccess) { fprintf(stderr, "kernel_launch: hipFuncSetAttribute failed\n"); grid = -1; return; }
        if (hipOccupancyMaxActiveBlocksPerMultiprocessor(&per_cu, (const void*)mega, NTHREADS, LDS_BYTES) != hipSuccess || per_cu < 1) { fprintf(stderr, "kernel_launch: occupancy query says %d\n", per_cu); per_cu = 1; }
        (void)hipGetLastError();
        grid = cus * 1;
    }
    if (grid < 0) return;
    (void)hipMemsetAsync((unsigned char*)d_ws + 16384, 0, 16384, stream);
    Args a{};
    for (int i = 0; i < 33; ++i) a.in[i] = d_in[i];
    a.out = (float*)d_out; a.ws = (unsigned char*)d_ws;
#if MK_MULTI
    for (int p = 0; p < NPHASE; ++p) { a.lo = p; a.hi = p + 1; hipLaunchKernelGGL(mega, dim3(grid), dim3(NTHREADS), LDS_BYTES, stream, a); }
#else
    a.lo = 0; a.hi = NPHASE;
    void* args[] = {&a};
    hipError_t e = hipLaunchCooperativeKernel((const void*)mega, dim3(grid), dim3(NTHREADS), args, LDS_BYTES, stream);
    if (e != hipSuccess) fprintf(stderr, "cooperative launch failed: %s (grid %d)\n", hipGetErrorString(e), grid);
#endif
}
```

```cpp
#include <hip/hip_runtime.h>
#include <hip/hip_cooperative_groups.h>
#include <cstdio>
#include <cstdint>
namespace cg = cooperative_groups;

#define LAS __attribute__((address_space(3)))
typedef unsigned short bf16_t;
typedef short bf16x8 __attribute__((ext_vector_type(8)));
typedef float f32x2 __attribute__((ext_vector_type(2)));
typedef float f32x4 __attribute__((ext_vector_type(4)));
typedef float f32x16 __attribute__((ext_vector_type(16)));
typedef unsigned u32x2 __attribute__((ext_vector_type(2)));
typedef unsigned u32x4 __attribute__((ext_vector_type(4)));

constexpr int NB = 8, S = 4096, D = 1024, DEPTH = 2;
constexpr int GB = 4, NGRP = NB / GB, TG = GB * S;
constexpr int RW_COLS = 1792, MLA_COLS = 416, DF_COLS = 1536, GT_COLS = 3072, IN_COLS = 6816;
constexpr int NP = 6912;
constexpr int DFF = 2816;
constexpr float LOG2E = 1.4426950408889634f;
constexpr float QSCALE_M = 0.10206207261596575f * LOG2E;
constexpr float QSCALE_D = 0.125f * LOG2E;
constexpr int NTHREADS = 512, NWAVES = 8;

constexpr size_t MiB = 1u << 20;
constexpr size_t WS_CTL = 0, WS_ROPE = 1 * MiB, WS_WT = 8 * MiB;
constexpr size_t WT_IN = WS_WT, WT_UQ = WT_IN + (size_t)NP * 1024 * 2, WT_UKV = WT_UQ + 768 * 256 * 2, WT_LORA = WT_UKV + 1024 * 128 * 2,
                 WT_BR = WT_LORA + 1536 * 256 * 2, WT_O = WT_BR + 3 * 1024 * 512 * 2, WT_UP = WT_O + 1024 * 1024 * 2, WT_DN = WT_UP + (size_t)5632 * 1024 * 2,
                 WT_END = WT_DN + (size_t)1024 * DFF * 2;
static_assert(WT_END <= 45 * MiB, "weights");
constexpr size_t WS_HB = 45 * MiB, WS_PRW = 77 * MiB, WS_PML = 133 * MiB, WS_QKD = 149 * MiB, WS_VTD = 181 * MiB, WS_GATE = 197 * MiB,
                 WS_CQN = 293 * MiB, WS_CKVN = 301 * MiB, WS_LIN = 305 * MiB, WS_QM = 313 * MiB, WS_KM = 337 * MiB, WS_VTM = 361 * MiB,
                 WS_WAG = 377 * MiB, WS_ORW = 425 * MiB, WS_OML = 441 * MiB, WS_ODF = 457 * MiB, WS_Y = 473 * MiB, WS_END = 505 * MiB, WS_RKB = 5 * MiB;
constexpr size_t WS_U = 77 * MiB, WS_ACT = 253 * MiB;
static_assert(WS_ACT + (size_t)TG * DFF * 2 <= 512 * MiB && WS_U + (size_t)TG * 5632 * 2 <= WS_ACT, "ffn overlay");

#define GA_ __attribute__((address_space(1)))
template <class T> __device__ __forceinline__ T ldg(const void* p) { return *(const GA_ T*)p; }
template <class T> __device__ __forceinline__ void stg(void* p, T v) { *(GA_ T*)p = v; }
typedef __bf16 bf16x2_native __attribute__((ext_vector_type(2)));
__device__ __forceinline__ unsigned cvt_pk_bf16(float lo, float hi) { const f32x2 v = {lo, hi}; const bf16x2_native b = __builtin_convertvector(v, bf16x2_native); return __builtin_bit_cast(unsigned, b); }
__device__ __forceinline__ float bflo(unsigned w) { return __builtin_bit_cast(float, w << 16); }
__device__ __forceinline__ float bfhi(unsigned w) { return __builtin_bit_cast(float, w & 0xffff0000u); }
__device__ __forceinline__ float bf2f(bf16_t h) { return __builtin_bit_cast(float, (unsigned)h << 16); }
__device__ __forceinline__ bf16_t f2bf(float f) { return (bf16_t)(cvt_pk_bf16(f, 0.f) & 0xffffu); }
__device__ __forceinline__ void store8(bf16_t* p, const float* v) {
    u32x4 w; w.x = cvt_pk_bf16(v[0], v[1]); w.y = cvt_pk_bf16(v[2], v[3]); w.z = cvt_pk_bf16(v[4], v[5]); w.w = cvt_pk_bf16(v[6], v[7]); *(u32x4*)p = w;
}
__device__ __forceinline__ void load8(const bf16_t* p, float* v) {
    const u32x4 w = ldg<u32x4>(p); v[0] = bflo(w.x); v[1] = bfhi(w.x); v[2] = bflo(w.y); v[3] = bfhi(w.y); v[4] = bflo(w.z); v[5] = bfhi(w.z); v[6] = bflo(w.w); v[7] = bfhi(w.w);
}
__device__ __forceinline__ void store8_nt(bf16_t* p, const float* v) {
    u32x4 w; w.x = cvt_pk_bf16(v[0], v[1]); w.y = cvt_pk_bf16(v[2], v[3]); w.z = cvt_pk_bf16(v[4], v[5]); w.w = cvt_pk_bf16(v[6], v[7]); __builtin_nontemporal_store(w, (GA_ u32x4*)p);
}
__device__ __forceinline__ void load8_nt(const bf16_t* p, float* v) {
    const u32x4 w = __builtin_nontemporal_load((const GA_ u32x4*)p); v[0] = bflo(w.x); v[1] = bfhi(w.x); v[2] = bflo(w.y); v[3] = bfhi(w.y); v[4] = bflo(w.z); v[5] = bfhi(w.z); v[6] = bflo(w.w); v[7] = bfhi(w.w);
}
__device__ __forceinline__ float sigmoidf_(float x) { return __builtin_amdgcn_rcpf(1.f + __expf(-x)); }
__device__ __forceinline__ float wave_sum(float v) {
#pragma unroll
    for (int o = 1; o < 64; o <<= 1) v += __shfl_xor(v, o);
    return v;
}

__device__ __forceinline__ int tid_opaque() { int t; asm volatile("v_mov_b32 %0, %1" : "=v"(t) : "v"((int)threadIdx.x)); __builtin_assume(t >= 0 && t < NTHREADS); return t; }
__device__ __forceinline__ int bid_opaque() { int t; asm volatile("s_mov_b32 %0, %1" : "=s"(t) : "s"((int)blockIdx.x)); __builtin_assume(t >= 0 && t < 1024); return t; }
struct Args { const void* in[33]; float* out; unsigned char* ws; int lo, hi; };
constexpr int ARGS_OFF = 150 * 1024 + 64;
__device__ __forceinline__ unsigned long long uni64(unsigned long long v) { const unsigned lo = __builtin_amdgcn_readfirstlane((unsigned)v), hi = __builtin_amdgcn_readfirstlane((unsigned)(v >> 32)); return ((unsigned long long)hi << 32) | lo; }
struct AP { const LAS unsigned long long* t;
    __device__ __forceinline__ const void* in(int i) const { return (const void*)uni64(t[i]); }
    __device__ __forceinline__ float* out() const { return (float*)uni64(t[33]); }
    __device__ __forceinline__ unsigned char* ws() const { return (unsigned char*)uni64(t[34]); } };
enum { I_X = 0, I_POS, I_RELB, I_NMIX, I_WIN, I_BGATE, I_MU, I_W0, I_W2, I_A0, I_A2, I_G2, I_KK, I_KA, I_RK, I_LNW, I_LNB, I_QNORM, I_WUQ, I_KVNORM, I_WUKV,
       I_LAM, I_SUBLN, I_WBR, I_WBM, I_WBD, I_WO, I_NFFN, I_WUP, I_CW, I_CB, I_WDN, I_NFIN };

#define XB_TMO      128
#define XB_XCNT(j)  (256  + 64 * (j))
#define XB_XSUB(j)  (1280 + 64 * (j))
#define XB_XGEN(j)  (2304 + 64 * (j))
#define XB_TOP      3328
#define XB_TOPGEN   3392
#define XCD_BAR_WORDS 3456
#define XB_SPIN_CAP (1u << 18)

__device__ __forceinline__ unsigned xb_ld(unsigned* p)              { return __hip_atomic_load(p, __ATOMIC_RELAXED, __HIP_MEMORY_SCOPE_AGENT); }
__device__ __forceinline__ unsigned xb_add(unsigned* p, unsigned v) { return __hip_atomic_fetch_add(p, v, __ATOMIC_RELAXED, __HIP_MEMORY_SCOPE_AGENT); }
__device__ __forceinline__ unsigned xb_xcc_id() { return (unsigned)__builtin_amdgcn_s_getreg((3 << 11) | 20) & 0xFu; }
#define XB_SPIN(cond, bar) do { unsigned _sp = 0; while (cond) { __builtin_amdgcn_s_sleep(1); \
    if ((++_sp & 255u) == 0u) { if (xb_ld(&(bar)[XB_TMO])) break; if (_sp > XB_SPIN_CAP) { atomicAdd(&(bar)[XB_TMO], 1u); break; } } } } while (0)

struct XcdBarrier {
    unsigned* bar; unsigned x;
    volatile LAS unsigned* st;
};

__device__ __forceinline__ XcdBarrier xcd_barrier_post(unsigned* bar, volatile LAS unsigned* st) {
    XcdBarrier b; b.bar = bar; b.x = xb_xcc_id(); b.st = st;
    if (threadIdx.x == 0) (void)xb_add(&bar[XB_XCNT(b.x)], 1u);
    return b;
}
__device__ __forceinline__ void xcd_barrier_complete(unsigned* bar, unsigned x, unsigned& nloc, unsigned& nx) {
    const unsigned G = gridDim.x * gridDim.y * gridDim.z;
    unsigned sum, cnt, mine, sp = 0u;
    for (;;) {
        sum = 0u; cnt = 0u; mine = 0u;
#pragma unroll
        for (unsigned j = 0; j < 16; ++j) { const unsigned c = xb_ld(&bar[XB_XCNT(j)]); sum += c; cnt += (c > 0u) ? 1u : 0u; mine = (j == x) ? c : mine; }
        if (sum == G) break;
        __builtin_amdgcn_s_sleep(1);
        if ((++sp & 255u) == 0u) { if (xb_ld(&bar[XB_TMO])) break; if (sp > XB_SPIN_CAP) { atomicAdd(&bar[XB_TMO], 1u); break; } }
    }
    nloc = mine > 0u ? mine : 1u; nx = cnt > 0u ? cnt : 1u;
}

__device__ __forceinline__ void xcd_barrier(const XcdBarrier& b) {
    asm volatile("s_waitcnt vmcnt(0)" ::: "memory");
    __syncthreads();
    if (threadIdx.x == 0) {
        unsigned* bar = b.bar;
        __builtin_amdgcn_s_waitcnt(0);
        unsigned nloc = b.st[0], nx = b.st[1];
        if (nloc == 0u) { xcd_barrier_complete(bar, b.x, nloc, nx); b.st[0] = nloc; b.st[1] = nx; }
        const unsigned old = xb_add(&bar[XB_XSUB(b.x)], 1u);
        const unsigned gen = old / nloc;
        if (old + 1u == (gen + 1u) * nloc) {
            __builtin_amdgcn_fence(__ATOMIC_RELEASE, "agent");
            asm volatile("s_waitcnt vmcnt(0)" ::: "memory");
            const unsigned og = xb_add(&bar[XB_TOP], 1u);
            const unsigned tg = og / nx;
            if (og + 1u == (tg + 1u) * nx) xb_add(&bar[XB_TOPGEN], 1u);
            else XB_SPIN(xb_ld(&bar[XB_TOPGEN]) == tg, bar);
            __builtin_amdgcn_fence(__ATOMIC_ACQUIRE, "agent");
            xb_add(&bar[XB_XGEN(b.x)], 1u);
            asm volatile("s_waitcnt vmcnt(0)" ::: "memory");
        } else {
            XB_SPIN(xb_ld(&bar[XB_XGEN(b.x)]) == gen, bar);
            __builtin_amdgcn_fence(__ATOMIC_ACQUIRE, "agent");
            asm volatile("s_waitcnt vmcnt(0)" ::: "memory");
        }
    }
    __syncthreads();
}

struct WSrc { const float* p; int ld; };
__device__ __forceinline__ WSrc wt_src(const AP a, int l, int wid, int kb, int n) {
    WSrc r; r.p = nullptr; r.ld = 0;
    const int k0 = kb * 64;
    switch (wid) {
    case 0: { const float* w = (const float*)a.in(I_WIN) + (size_t)l * 1024 * IN_COLS; int col;
              if (n < 1792) col = n; else if (n < 2304) { col = (n - 1792 < MLA_COLS) ? n : -1; } else if (n < 3840) col = 2208 + (n - 2304); else col = 3744 + (n - 3840);
              if (col >= 0) { r.p = w + (size_t)k0 * IN_COLS + col; r.ld = IN_COLS; } } break;
    case 1: { const float* w = (const float*)a.in(I_WUQ) + (size_t)l * 256 * 768; const int hd = n / 96, ww = n % 96; int col = n;
              if (ww >= 64) { const int i = (ww - 64) >> 1, p = (ww - 64) & 1; col = hd * 96 + 64 + i + 16 * p; }
              r.p = w + (size_t)k0 * 768 + col; r.ld = 768; } break;
    case 2: { const float* w = (const float*)a.in(I_WUKV) + (size_t)l * 128 * 1024; r.p = w + (size_t)k0 * 1024 + n; r.ld = 1024; } break;
    case 3: { if (n < 512) { if (kb == 0) { r.p = (const float*)a.in(I_W2) + (size_t)l * 64 * 512 + n; r.ld = 512; } }
              else if (n < 1024) { if (kb == 1) { r.p = (const float*)a.in(I_A2) + (size_t)l * 64 * 512 + (n - 512); r.ld = 512; } }
              else { if (kb >= 2) { r.p = (const float*)a.in(I_G2) + (size_t)l * 128 * 512 + (size_t)(k0 - 128) * 512 + (n - 1024); r.ld = 512; } } } break;
    case 4: case 5: case 6: { const float* w = (const float*)a.in(I_WBR + (wid - 4)) + (size_t)l * 512 * 1024; r.p = w + (size_t)k0 * 1024 + n; r.ld = 1024; } break;
    case 7: { const float* w = (const float*)a.in(I_WO) + (size_t)l * 1024 * 1024; r.p = w + (size_t)k0 * 1024 + n; r.ld = 1024; } break;
    case 8: { const float* w = (const float*)a.in(I_WUP) + (size_t)l * 1024 * 5632; r.p = w + (size_t)k0 * 5632 + n; r.ld = 5632; } break;
    default: { const float* w = (const float*)a.in(I_WDN) + (size_t)l * DFF * 1024; r.p = w + (size_t)k0 * 1024 + n; r.ld = 1024; } break;
    }
    return r;
}
__device__ __forceinline__ void wt_convert(const AP a, int l, LAS float* scr, int gw, int ngw, int lane) {
    constexpr int NWT = 10;
    int base = 0;
#pragma unroll 1
    for (int w = 0; w < NWT; ++w) {
        int Npw, K; size_t offw;
        switch (w) {
        case 0: Npw = NP; K = 1024; offw = WT_IN; break;
        case 1: Npw = 768; K = 256; offw = WT_UQ; break;
        case 2: Npw = 1024; K = 128; offw = WT_UKV; break;
        case 3: Npw = 1536; K = 256; offw = WT_LORA; break;
        case 4: Npw = 1024; K = 512; offw = WT_BR; break;
        case 5: Npw = 1024; K = 512; offw = WT_BR + 1024 * 512 * 2; break;
        case 6: Npw = 1024; K = 512; offw = WT_BR + 2 * 1024 * 512 * 2; break;
        case 7: Npw = 1024; K = 1024; offw = WT_O; break;
        case 8: Npw = 5632; K = 1024; offw = WT_UP; break;
        default: Npw = 1024; K = DFF; offw = WT_DN; break;
        }
        const int nblk = Npw / 32, nitems = (K / 64) * nblk;
        bf16_t* WT = (bf16_t*)(a.ws() + offw);
        int it = gw - (base % ngw); if (it < 0) it += ngw;
#pragma unroll 1
        for (; it < nitems; it += ngw) {
            const int kb = it / nblk, nb = it % nblk, k0 = 64 * kb, n0 = 32 * nb;
            const WSrc s = wt_src(a, l, w, kb, n0 + (lane & 31));
#pragma unroll 8
            for (int i = 0; i < 32; ++i) { const int kk = 2 * i + (lane >> 5); scr[kk * 33 + (lane & 31)] = s.p ? s.p[(size_t)kk * s.ld] : 0.f; }
            asm volatile("s_waitcnt lgkmcnt(0)" ::: "memory");
            const int c = lane & 7;
#pragma unroll
            for (int j = 0; j < 4; ++j) { const int n = (lane >> 3) + 8 * j; const LAS float* sp = scr + (8 * c) * 33 + n;
                u32x4 o; o.x = cvt_pk_bf16(sp[0 * 33], sp[1 * 33]); o.y = cvt_pk_bf16(sp[2 * 33], sp[3 * 33]); o.z = cvt_pk_bf16(sp[4 * 33], sp[5 * 33]); o.w = cvt_pk_bf16(sp[6 * 33], sp[7 * 33]);
                stg<u32x4>(WT + (size_t)(n0 + n) * K + k0 + 8 * c, o); }
            asm volatile("s_waitcnt lgkmcnt(0)" ::: "memory");
        }
        base += nitems;
    }
}

__device__ __forceinline__ void rmsnorm_rows(const float* x, const float* gain, bf16_t* o, int nrows, int gw, int ngw, int lane) {
    f32x4 gv[4];
#pragma unroll
    for (int j = 0; j < 4; ++j) gv[j] = ldg<f32x4>((const f32x4*)gain + lane + 64 * j);
#pragma unroll 1
    for (int r = gw; r < nrows; r += 2 * ngw) {
        const int r2 = r + ngw; const bool has2 = r2 < nrows; const int rb = has2 ? r2 : r;
        const f32x4* xa = (const f32x4*)(x + (size_t)r * D) + lane; const f32x4* xb = (const f32x4*)(x + (size_t)rb * D) + lane; f32x4 va[4], vb[4]; float sa = 0.f, sb = 0.f;
#pragma unroll
        for (int j = 0; j < 4; ++j) { va[j] = ldg<f32x4>(xa + 64 * j); vb[j] = ldg<f32x4>(xb + 64 * j); }
#pragma unroll
        for (int j = 0; j < 4; ++j) { sa += (va[j].x * va[j].x + va[j].y * va[j].y) + (va[j].z * va[j].z + va[j].w * va[j].w); sb += (vb[j].x * vb[j].x + vb[j].y * vb[j].y) + (vb[j].z * vb[j].z + vb[j].w * vb[j].w); }
#pragma unroll
        for (int of = 1; of < 64; of <<= 1) { sa += __shfl_xor(sa, of); sb += __shfl_xor(sb, of); }
        const float ra = rsqrtf(sa * (1.f / D) + 1e-6f), rbb = rsqrtf(sb * (1.f / D) + 1e-6f);
        u32x2* oa = (u32x2*)(o + (size_t)r * D) + lane; u32x2* ob = (u32x2*)(o + (size_t)rb * D) + lane;
#pragma unroll
        for (int j = 0; j < 4; ++j) { u32x2 w; w.x = cvt_pk_bf16(va[j].x * ra * gv[j].x, va[j].y * ra * gv[j].y); w.y = cvt_pk_bf16(va[j].z * ra * gv[j].z, va[j].w * ra * gv[j].w); stg<u32x2>(oa + 64 * j, w); }
        if (has2) {
#pragma unroll
            for (int j = 0; j < 4; ++j) { u32x2 w; w.x = cvt_pk_bf16(vb[j].x * rbb * gv[j].x, vb[j].y * rbb * gv[j].y); w.y = cvt_pk_bf16(vb[j].z * rbb * gv[j].z, vb[j].w * rbb * gv[j].w); stg<u32x2>(ob + 64 * j, w); } }
    }
}
__device__ __forceinline__ void rmsnorm_rows_f32(float* x, const float* gain, int nrows, int gw, int ngw, int lane) {
    f32x4 gv[4];
#pragma unroll
    for (int j = 0; j < 4; ++j) gv[j] = *((const f32x4*)gain + lane + 64 * j);
#pragma unroll 1
    for (int r = gw; r < nrows; r += ngw) {
        f32x4* xr = (f32x4*)(x + (size_t)r * D) + lane; f32x4 v[4]; float s = 0.f;
#pragma unroll
        for (int j = 0; j < 4; ++j) { v[j] = xr[64 * j]; s += (v[j].x * v[j].x + v[j].y * v[j].y) + (v[j].z * v[j].z + v[j].w * v[j].w); }
        const float rs = rsqrtf(wave_sum(s) * (1.f / D) + 1e-6f);
#pragma unroll
        for (int j = 0; j < 4; ++j) xr[64 * j] = v[j] * rs * gv[j];
    }
}
namespace pg8 {
#define PG8_LAS __attribute__((address_space(3)))
constexpr int BM = 256, BK = 64, HALF = 128, HTB = HALF * BK * 2  , STAGE_BYTES = 8 * HTB, NXCD = 8, WGM = 8;

__host__ __device__ __forceinline__ int lds_byte(int r, int c) { const int st = (r >> 4) * 2 + (c >> 5), rr = r & 15, cc = c & 31, ob = rr * 64 + cc * 2; return st * 1024 + (ob ^ (((ob >> 9) & 1) << 5)); }
__host__ __device__ __forceinline__ void stage_rc(int b, int& R, int& C) { const int st = b / 1024, sb = b % 1024, swz = sb ^ (((sb >> 9) & 1) << 5); R = (st >> 1) * 16 + swz / 64; C = (st & 1) * 32 + (swz % 64) / 2; }
__host__ __device__ __forceinline__ int perm32(int rho) { const int n = rho >> 4, i = rho & 15; return 8 * (i >> 2) + 4 * n + (i & 3); }

struct Unit { int pm, pn, br; };
struct Gemm { const bf16_t* A; const bf16_t* Bt; int M, N, K, lda; size_t brA, brB; };

struct StaticOrder {
    int nM, nN, nwg, G, c, nbr;
    __host__ __device__ void init(int M, int N, int G_, int c_) { nM = M / BM; nN = N / BM; nwg = nM * nN; G = G_; c = c_; nbr = 1; }
    __host__ __device__ bool next(int i, Unit& u) const {
        const int it = i / nbr; u.br = i - it * nbr;
        const long L = (long)it * G + c; if (L >= nwg) return false;
        int wgid = (int)L; { const int q = nwg / NXCD, r = nwg % NXCD, xcd = wgid % NXCD, off = wgid / NXCD; wgid = (xcd < r ? xcd * (q + 1) : r * (q + 1) + (xcd - r) * q) + off; }
        const int nig = WGM * nN, gid = wgid / nig, fm = gid * WGM, gsz = (nM - fm) < WGM ? (nM - fm) : WGM;
        u.pm = fm + ((wgid % nig) % gsz); u.pn = (wgid % nig) / gsz; return true;
    }
    __device__ __forceinline__ void a_ready(const Unit&) const {}
    __device__ __forceinline__ void done(const Unit&) const {}
};

template <class Epi, class Sched, bool ALIGN_EPI = false, bool SP2 = false>
__device__ __forceinline__ void gemm_phase(PG8_LAS unsigned char* lds, const Gemm g, const Sched& S, const Epi& E) {
    const int tid = tid_opaque(), wid = __builtin_amdgcn_readfirstlane(tid >> 6), lane = tid & 63, wr = wid >> 2, wc = wid & 3, fr = lane & 15, fq = lane >> 4;
    const int K = g.K, nt = K / BK;
    unsigned voffA[2], voffB[2];
#pragma unroll
    for (int i = 0; i < 2; ++i) { int R, C; stage_rc(tid * 16 + i * 8192, R, C); const int Rb = Epi::PERM ? ((R & ~31) + perm32(R & 31)) : R;
        voffA[i] = (unsigned)(R * g.lda + C) * 2u; voffB[i] = (unsigned)(Rb * K + C) * 2u; }
    const size_t kstep = (size_t)(BK * 2);
    const size_t hstepB = (size_t)HALF * K * 2, tstepB = 2 * hstepB;
    const size_t hstepA = (size_t)HALF * g.lda * 2, tstepA = 2 * hstepA;
    const unsigned ldsw = (unsigned)wid * 1024u;
    const int aoff = lds_byte(wr * 64 + fr, fq * 8), boff = lds_byte(wc * 32 + fr, fq * 8);
#define PG8_SA(b, h) (((b) * 2 + (h)) * HTB)
#define PG8_SB(b, h) ((4 + (b) * 2 + (h)) * HTB)
#define PG8_STAGE(bufoff, gbase, voff) do { _Pragma("unroll") for (int _i = 0; _i < 2; ++_i) \
        __builtin_amdgcn_global_load_lds((const unsigned*)((const char*)(gbase) + (voff)[_i]), (PG8_LAS unsigned*)(lds + (bufoff) + ldsw + _i * 8192), 16, 0, 0); } while (0)
#define PG8_LDA(dst, b, h) do { _Pragma("unroll") for (int m = 0; m < 4; ++m) _Pragma("unroll") for (int k = 0; k < 2; ++k) dst[m][k] = *(const PG8_LAS bf16x8*)(lds + PG8_SA(b, h) + aoff + m * 2048 + k * 1024); } while (0)
#define PG8_LDB(dst, b, h) do { _Pragma("unroll") for (int n = 0; n < 2; ++n) _Pragma("unroll") for (int k = 0; k < 2; ++k) dst[n][k] = *(const PG8_LAS bf16x8*)(lds + PG8_SB(b, h) + boff + n * 2048 + k * 1024); } while (0)
#define PG8_MMA(ai, bj, At, Bt) do { __builtin_amdgcn_s_setprio(1); _Pragma("unroll") for (int m = 0; m < 4; ++m) _Pragma("unroll") for (int n = 0; n < 2; ++n) _Pragma("unroll") for (int k = 0; k < 2; ++k) \
        acc[ai][bj][m][n] = __builtin_amdgcn_mfma_f32_16x16x32_bf16(Bt[n][k], At[m][k], acc[ai][bj][m][n], 0, 0, 0); __builtin_amdgcn_s_setprio(0); } while (0)
#define PG8_WAIT_V(n) asm volatile("s_waitcnt vmcnt(" #n ")" ::: "memory")
#define PG8_WAIT_L(n) asm volatile("s_waitcnt lgkmcnt(" #n ")" ::: "memory")
#define PG8_BAR __builtin_amdgcn_s_barrier()
#define PG8_SCHED __builtin_amdgcn_sched_barrier(0)
    Unit cur, nxt; int ui = 0;
    if (!S.next(0, cur)) return;
    f32x4 acc[2][2][4][2];
#pragma unroll
    for (int a = 0; a < 2; ++a)
#pragma unroll
        for (int b = 0; b < 2; ++b)
#pragma unroll
            for (int m = 0; m < 4; ++m)
#pragma unroll
                for (int n = 0; n < 2; ++n) acc[a][b][m][n] = (f32x4){0.f, 0.f, 0.f, 0.f};
    bf16x8 At[4][2], B0[2][2], B1[2][2];
    const char* cA = (const char*)g.A + (size_t)cur.pm * tstepA + (size_t)cur.br * g.brA; const char* cB = (const char*)g.Bt + (size_t)cur.pn * tstepB + (size_t)cur.br * g.brB;
    S.a_ready(cur);
    if constexpr (SP2) {
        PG8_STAGE(PG8_SB(0, 0), cB, voffB); PG8_STAGE(PG8_SB(0, 1), cB + hstepB, voffB); PG8_STAGE(PG8_SA(0, 0), cA, voffA); PG8_STAGE(PG8_SA(0, 1), cA + hstepA, voffA);
        if (wr == 1) PG8_BAR;
        PG8_WAIT_V(2); PG8_BAR;
        PG8_STAGE(PG8_SB(1, 0), cB + kstep, voffB); PG8_STAGE(PG8_SA(1, 0), cA + kstep, voffA); PG8_STAGE(PG8_SB(1, 1), cB + hstepB + kstep, voffB);
        PG8_WAIT_V(6); PG8_BAR;
    } else {
        PG8_STAGE(PG8_SB(0, 0), cB, voffB); PG8_STAGE(PG8_SA(0, 0), cA, voffA); PG8_STAGE(PG8_SB(0, 1), cB + hstepB, voffB); PG8_STAGE(PG8_SA(0, 1), cA + hstepA, voffA);
        if (wr == 1) PG8_BAR;
        PG8_WAIT_V(4); PG8_BAR;
        PG8_STAGE(PG8_SB(1, 0), cB + kstep, voffB); PG8_STAGE(PG8_SA(1, 0), cA + kstep, voffA); PG8_STAGE(PG8_SB(1, 1), cB + hstepB + kstep, voffB);
        PG8_WAIT_V(6); PG8_BAR;
    }
    for (;;) {
        const bool has_next = S.next(ui + 1, nxt);
        const char* nA = has_next ? (const char*)g.A + (size_t)nxt.pm * tstepA + (size_t)nxt.br * g.brA : cA; const char* nB = has_next ? (const char*)g.Bt + (size_t)nxt.pn * tstepB + (size_t)nxt.br * g.brB : cB;
        for (int t = 0; t < nt; t += 2) {
            const bool last = (t == nt - 2);
            const char* a1 = cA + (size_t)(t + 1) * kstep;
            const char* a2 = last ? nA : cA + (size_t)(t + 2) * kstep; const char* b2 = last ? nB : cB + (size_t)(t + 2) * kstep;
            const char* a3 = a2 + kstep; const char* b3 = b2 + kstep;
            if (last && has_next) S.a_ready(nxt);
            if constexpr (SP2) {
            PG8_LDB(B0, 0, 0); PG8_LDB(B1, 0, 1); PG8_SCHED; PG8_LDA(At, 0, 0); PG8_STAGE(PG8_SA(1, 1), a1 + hstepA, voffA);
            PG8_WAIT_V(8); PG8_WAIT_L(0); PG8_BAR; PG8_MMA(0, 0, At, B0); PG8_MMA(0, 1, At, B1); PG8_BAR; PG8_SCHED;
            PG8_LDA(At, 0, 1); PG8_STAGE(PG8_SB(0, 0), b2, voffB); PG8_STAGE(PG8_SB(0, 1), b2 + hstepB, voffB); PG8_STAGE(PG8_SA(0, 0), a2, voffA);
            PG8_WAIT_V(8); PG8_WAIT_L(0); PG8_BAR; PG8_MMA(1, 0, At, B0); PG8_MMA(1, 1, At, B1); PG8_BAR; PG8_SCHED;
            PG8_LDB(B0, 1, 0); PG8_LDB(B1, 1, 1); PG8_SCHED; PG8_LDA(At, 1, 0); PG8_STAGE(PG8_SA(0, 1), a2 + hstepA, voffA);
            PG8_WAIT_V(8); PG8_WAIT_L(0); PG8_BAR; PG8_MMA(0, 0, At, B0); PG8_MMA(0, 1, At, B1); PG8_BAR; PG8_SCHED;
            PG8_LDA(At, 1, 1); PG8_STAGE(PG8_SB(1, 0), b3, voffB); PG8_STAGE(PG8_SB(1, 1), b3 + hstepB, voffB); PG8_STAGE(PG8_SA(1, 0), a3, voffA);
            PG8_WAIT_V(8); PG8_WAIT_L(0); PG8_BAR; PG8_MMA(1, 0, At, B0); PG8_MMA(1, 1, At, B1); PG8_BAR; PG8_SCHED;
            } else {
            PG8_LDB(B0, 0, 0); PG8_SCHED; PG8_LDA(At, 0, 0); PG8_STAGE(PG8_SA(1, 1), a1 + hstepA, voffA);
            PG8_WAIT_L(8); PG8_BAR; PG8_WAIT_L(0); PG8_MMA(0, 0, At, B0); PG8_BAR; PG8_SCHED;
            PG8_LDB(B1, 0, 1); PG8_STAGE(PG8_SB(0, 0), b2, voffB);
            PG8_BAR; PG8_WAIT_L(0); PG8_MMA(0, 1, At, B1); PG8_BAR;
            PG8_LDA(At, 0, 1); PG8_STAGE(PG8_SA(0, 0), a2, voffA);
            PG8_BAR; PG8_WAIT_L(0); PG8_MMA(1, 0, At, B0); PG8_BAR; PG8_SCHED;
            PG8_STAGE(PG8_SB(0, 1), b2 + hstepB, voffB);
            PG8_WAIT_V(6); PG8_BAR; PG8_MMA(1, 1, At, B1); PG8_BAR;
            PG8_LDB(B0, 1, 0); PG8_SCHED; PG8_LDA(At, 1, 0); PG8_STAGE(PG8_SA(0, 1), a2 + hstepA, voffA);
            PG8_WAIT_L(8); PG8_BAR; PG8_WAIT_L(0); PG8_MMA(0, 0, At, B0); PG8_BAR; PG8_SCHED;
            PG8_LDB(B1, 1, 1); PG8_STAGE(PG8_SB(1, 0), b3, voffB);
            PG8_BAR; PG8_WAIT_L(0); PG8_MMA(0, 1, At, B1); PG8_BAR;
            PG8_LDA(At, 1, 1); PG8_STAGE(PG8_SA(1, 0), a3, voffA);
            PG8_BAR; PG8_WAIT_L(0); PG8_MMA(1, 0, At, B0); PG8_BAR; PG8_SCHED;
            PG8_STAGE(PG8_SB(1, 1), b3 + hstepB, voffB);
            PG8_WAIT_V(6); PG8_BAR; PG8_MMA(1, 1, At, B1); PG8_BAR;
            }
        }
        if constexpr (ALIGN_EPI) { if (wr == 0) PG8_BAR; }
        bool keep_acc = false;
        if constexpr (!Epi::AFTER_DRAIN) { keep_acc = E.apply(acc, cur, wr, wc, fr, fq); S.done(cur); }
        if (!has_next) break;
        if (!keep_acc) {
#pragma unroll
        for (int a = 0; a < 2; ++a)
#pragma unroll
            for (int b = 0; b < 2; ++b)
#pragma unroll
                for (int m = 0; m < 4; ++m)
#pragma unroll
                    for (int n = 0; n < 2; ++n) acc[a][b][m][n] = (f32x4){0.f, 0.f, 0.f, 0.f};
        }
        cur = nxt; cA = nA; cB = nB; ++ui;
        if constexpr (ALIGN_EPI) { if (wr == 1) PG8_BAR; }
    }
    PG8_WAIT_V(0);
    if constexpr (!ALIGN_EPI) { if (wr == 0) PG8_BAR; }
    PG8_BAR;
    if constexpr (Epi::AFTER_DRAIN) { E.fused(acc, cur, wr, wc, fr, fq, lds, wid, lane); S.done(cur); }
#undef PG8_SA
#undef PG8_SB
#undef PG8_STAGE
#undef PG8_LDA
#undef PG8_LDB
#undef PG8_MMA
#undef PG8_WAIT_V
#undef PG8_WAIT_L
#undef PG8_BAR
#undef PG8_SCHED
}
}


enum { K_P = 0, K_Q, K_KV, K_LORA, K_BR, K_WO, K_UP, K_DN, K_BR3 };
struct Epi {
    static constexpr bool PERM = true, AFTER_DRAIN = false;
    int kind, aux, grp, pad;
    unsigned char* ws;
    const float* f0; const float* f1;
    const float* xi; float* xo;
    __device__ __forceinline__ void emit(int row, int pn, int col0, float* v) const {
        switch (kind) {
        case K_P: {
            if (pn < 7) store8((bf16_t*)(ws + WS_PRW) + (size_t)row * RW_COLS + col0, v);
            else if (pn < 9) store8((bf16_t*)(ws + WS_PML) + (size_t)row * 512 + (col0 - 1792), v);
            else if (pn < 13) { const int cq = col0 - 2304; if (cq < 512) {
#pragma unroll
                    for (int j = 0; j < 8; ++j) v[j] *= QSCALE_D; }
                store8((bf16_t*)(ws + WS_QKD) + (size_t)row * 1024 + cq, v); }
            else if (pn < 15) { const int cv = col0 - 3328, hh = cv >> 7, dv = cv & 127, bl = row >> 12, s = row & 4095;
                bf16_t* p = (bf16_t*)(ws + WS_VTD) + ((size_t)(bl * 4 + hh) * 128 + dv) * S + s;
#pragma unroll
                for (int j = 0; j < 8; ++j) p[(size_t)j * S] = f2bf(v[j]); }
            else { const int cg_ = col0 - 3840; const f32x4 b0 = ldg<f32x4>(f0 + cg_), b1 = ldg<f32x4>(f0 + cg_ + 4);
                v[0] = sigmoidf_(v[0] + b0.x); v[1] = sigmoidf_(v[1] + b0.y); v[2] = sigmoidf_(v[2] + b0.z); v[3] = sigmoidf_(v[3] + b0.w);
                v[4] = sigmoidf_(v[4] + b1.x); v[5] = sigmoidf_(v[5] + b1.y); v[6] = sigmoidf_(v[6] + b1.z); v[7] = sigmoidf_(v[7] + b1.w);
                store8((bf16_t*)(ws + WS_GATE) + (size_t)row * GT_COLS + cg_, v); }
        } break;
        case K_Q: {
            const int hd = col0 / 96, w = col0 - hd * 96, bl = row >> 12, s = row & 4095;
            if (w >= 64) { const f32x2* rt = (const f32x2*)(ws + WS_ROPE) + ((size_t)(grp * GB + bl) * S + s) * 16 + ((w - 64) >> 1);
#pragma unroll
                for (int jj = 0; jj < 4; ++jj) { const f32x2 cs = rt[jj]; const float x1 = v[2 * jj], x2 = v[2 * jj + 1]; v[2 * jj] = x1 * cs.x - x2 * cs.y; v[2 * jj + 1] = x1 * cs.y + x2 * cs.x; } }
#pragma unroll
            for (int j = 0; j < 8; ++j) v[j] *= QSCALE_M;
            store8((bf16_t*)(ws + WS_QM) + ((size_t)(bl * 8 + hd) * S + s) * 96 + w, v);
        } break;
        case K_KV: {
            const int hd = col0 >> 7, w = col0 & 127, bl = row >> 12, s = row & 4095;
            if (w < 64) store8((bf16_t*)(ws + WS_KM) + ((size_t)(bl * 8 + hd) * S + s) * 96 + w, v);
            else { bf16_t* p = (bf16_t*)(ws + WS_VTM) + ((size_t)(bl * 8 + hd) * 64 + (w - 64)) * S + s;
#pragma unroll
                for (int j = 0; j < 8; ++j) p[(size_t)j * S] = f2bf(v[j]); }
        } break;
        case K_LORA: {
            if (col0 < 512) {
#pragma unroll
                for (int j = 0; j < 8; ++j) v[j] = 0.6065306597126334f * sigmoidf_(v[j] + f0[col0 + j]); }
            else if (col0 < 1024) {
#pragma unroll
                for (int j = 0; j < 8; ++j) v[j] = sigmoidf_(v[j] + f1[col0 - 512 + j]); }
            store8((bf16_t*)(ws + WS_WAG) + (size_t)row * 1536 + col0, v);
        } break;
        case K_BR: {
            float gt[8]; load8((const bf16_t*)(ws + WS_GATE) + (size_t)row * GT_COLS + aux * 1024 + col0, gt);
            bf16_t* mp = (bf16_t*)(ws + WS_HB) + (size_t)row * 1024 + col0;
            if (aux > 0) { float o[8]; load8(mp, o);
#pragma unroll
                for (int j = 0; j < 8; ++j) v[j] = o[j] + gt[j] * v[j]; }
            else {
#pragma unroll
                for (int j = 0; j < 8; ++j) v[j] = gt[j] * v[j]; }
            store8(mp, v);
        } break;
        case K_WO: case K_DN: {
            const size_t o = ((size_t)grp * TG + row) * D + col0;
            const f32x4 a0 = ldg<f32x4>(xi + o), a1 = ldg<f32x4>(xi + o + 4);
            f32x4 r0, r1; r0.x = a0.x + v[0]; r0.y = a0.y + v[1]; r0.z = a0.z + v[2]; r0.w = a0.w + v[3]; r1.x = a1.x + v[4]; r1.y = a1.y + v[5]; r1.z = a1.z + v[6]; r1.w = a1.w + v[7];
            stg<f32x4>(xo + o, r0); stg<f32x4>(xo + o + 4, r1);
        } break;
        default: {
            store8_nt((bf16_t*)(ws + WS_U) + (size_t)row * 5632 + col0, v);
        } break;
        }
    }
    __device__ __forceinline__ bool apply(f32x4 (&acc)[2][2][4][2], const pg8::Unit& u, int wr, int wc, int fr, int fq) const {
        if (kind != K_BR3) { (*this)(acc, u, wr, wc, fr, fq); return false; }
        const int row0 = u.pm * 256 + wr * 64 + fr, colb = u.pn * 256 + wc * 32 + 8 * fq, br = u.br;
        const bf16_t* G = (const bf16_t*)(ws + WS_GATE); bf16_t* Mb = (bf16_t*)(ws + WS_HB);
#pragma unroll
        for (int ai = 0; ai < 2; ++ai)
#pragma unroll
            for (int m = 0; m < 4; ++m)
#pragma unroll
                for (int bj = 0; bj < 2; ++bj) { const int row = row0 + ai * 128 + m * 16, col0 = colb + bj * 128;
                    float gc[8], gn[8]; load8(G + (size_t)row * GT_COLS + br * 1024 + col0, gc);
                    if (br < 2) load8(G + (size_t)row * GT_COLS + (br + 1) * 1024 + col0, gn);
                    else {
#pragma unroll
                        for (int j = 0; j < 8; ++j) gn[j] = 1.f; }
                    float v[8]; const f32x4 v0 = acc[ai][bj][m][0], v1 = acc[ai][bj][m][1];
                    v[0] = v0.x; v[1] = v0.y; v[2] = v0.z; v[3] = v0.w; v[4] = v1.x; v[5] = v1.y; v[6] = v1.z; v[7] = v1.w;
#pragma unroll
                    for (int j = 0; j < 8; ++j) v[j] *= fmaxf(gc[j], 1e-4f);
                    if (br == 2) store8(Mb + (size_t)row * 1024 + col0, v);
                    else {
#pragma unroll
                        for (int j = 0; j < 8; ++j) v[j] *= __builtin_amdgcn_rcpf(fmaxf(gn[j], 1e-4f));
                        acc[ai][bj][m][0] = (f32x4){v[0], v[1], v[2], v[3]}; acc[ai][bj][m][1] = (f32x4){v[4], v[5], v[6], v[7]}; }
                }
        return br < 2;
    }
    __device__ __forceinline__ void operator()(const f32x4 (&acc)[2][2][4][2], const pg8::Unit& u, int wr, int wc, int fr, int fq) const {
        const int row0 = u.pm * 256 + wr * 64 + fr, colb = u.pn * 256 + wc * 32 + 8 * fq;
#pragma unroll
        for (int ai = 0; ai < 2; ++ai)
#pragma unroll
            for (int m = 0; m < 4; ++m)
#pragma unroll
                for (int bj = 0; bj < 2; ++bj) {
                    float v[8]; const f32x4 v0 = acc[ai][bj][m][0], v1 = acc[ai][bj][m][1];
                    v[0] = v0.x; v[1] = v0.y; v[2] = v0.z; v[3] = v0.w; v[4] = v1.x; v[5] = v1.y; v[6] = v1.z; v[7] = v1.w;
                    emit(row0 + ai * 128 + m * 16, u.pn, colb + bj * 128, v);
                }
    }
};
struct SingleOrder { int pm, pn, cnt;
    __device__ __forceinline__ bool next(int i, pg8::Unit& u) const { if (i >= cnt) return false; u.pm = pm; u.pn = pn + i; u.br = 0; return true; }
    __device__ __forceinline__ void a_ready(const pg8::Unit&) const {}
    __device__ __forceinline__ void done(const pg8::Unit&) const {} };
__device__ __forceinline__ void run_gemm_unit(LAS unsigned char* lds, const bf16_t* A, int lda, const bf16_t* Bt, int M, int N, int K, const Epi& E, int pm, int pn, int cnt) {
    pg8::Gemm g{A, Bt, M, N, K, lda}; SingleOrder So; So.pm = pm; So.pn = pn; So.cnt = cnt;
    pg8::gemm_phase<Epi, SingleOrder, false, true>((PG8_LAS unsigned char*)lds, g, So, E);
}
__device__ __forceinline__ void run_gemm(LAS unsigned char* lds, const bf16_t* A, int lda, const bf16_t* Bt, int M, int N, int K, const Epi& E, int nbr, size_t brA, size_t brB) {
    pg8::Gemm g{A, Bt, M, N, K, lda, brA, brB}; pg8::StaticOrder So; So.init(M, N, (int)gridDim.x, bid_opaque()); So.nbr = nbr;
    pg8::gemm_phase<Epi, pg8::StaticOrder, true, true>((PG8_LAS unsigned char*)lds, g, So, E);
}

__device__ __forceinline__ void prologue_phase(const AP a) {
    const int gt = bid_opaque() * NTHREADS + tid_opaque(), ngt = gridDim.x * NTHREADS;
    const int* pos = (const int*)a.in(I_POS);
    f32x2* rt = (f32x2*)(a.ws() + WS_ROPE);
    for (int i = gt; i < NB * S * 16; i += ngt) {
        const int f = i & 15; const float inv = powf(10000.f, -(float)(2 * f) / 32.f);
        const float ang = (float)pos[i >> 4] * inv; float sn, cs; sincosf(ang, &sn, &cs);
        f32x2 o; o.x = cs; o.y = sn; rt[i] = o;
    }
    if (gt < 64) ((unsigned*)(a.ws() + WS_CTL))[gt] = 0u;
}

__device__ __forceinline__ void c1_phase(const AP a, int l, int grp, int gw, int ngw, int lane) {
    const bf16_t* PML = (const bf16_t*)(a.ws() + WS_PML); const bf16_t* PRW = (const bf16_t*)(a.ws() + WS_PRW);
    bf16_t* CQN = (bf16_t*)(a.ws() + WS_CQN); bf16_t* CKVN = (bf16_t*)(a.ws() + WS_CKVN); bf16_t* LIN = (bf16_t*)(a.ws() + WS_LIN); bf16_t* KM = (bf16_t*)(a.ws() + WS_KM);
    const float* qn = (const float*)a.in(I_QNORM) + l * 256; const float* kvn = (const float*)a.in(I_KVNORM) + l * 128; const float* mu = (const float*)a.in(I_MU) + l * RW_COLS + 1536;
    const f32x2* rt = (const f32x2*)(a.ws() + WS_ROPE);
    const f32x4 qg = ldg<f32x4>(qn + 4 * lane); const f32x2 kg = ldg<f32x2>(kvn + 2 * lane); const f32x4 mu4 = ldg<f32x4>(mu + 4 * lane);
#pragma unroll 2
    for (int row = gw; row < TG; row += ngw) {
        const int bl = row >> 12, s = row & 4095;
        { const u32x2 w = ldg<u32x2>(PML + (size_t)row * 512 + 4 * lane); const float f0 = bflo(w.x), f1 = bfhi(w.x), f2 = bflo(w.y), f3 = bfhi(w.y);
          const float rs = rsqrtf(wave_sum(f0 * f0 + f1 * f1 + f2 * f2 + f3 * f3) * (1.f / 256.f) + 1e-6f);
          u32x2 o; o.x = cvt_pk_bf16(f0 * rs * qg.x, f1 * rs * qg.y); o.y = cvt_pk_bf16(f2 * rs * qg.z, f3 * rs * qg.w); stg<u32x2>(CQN + (size_t)row * 256 + 4 * lane, o); }
        { const unsigned w = ldg<unsigned>(PML + (size_t)row * 512 + 256 + 2 * lane); const float f0 = bflo(w), f1 = bfhi(w);
          const float rs = rsqrtf(wave_sum(f0 * f0 + f1 * f1) * (1.f / 128.f) + 1e-6f);
          stg<unsigned>(CKVN + (size_t)row * 128 + 2 * lane, cvt_pk_bf16(f0 * rs * kg.x, f1 * rs * kg.y)); }
        if (lane < 16) { const float x1 = bf2f(PML[(size_t)row * 512 + 384 + lane]), x2 = bf2f(PML[(size_t)row * 512 + 400 + lane]);
          const f32x2 cs = rt[((size_t)(grp * GB + bl) * S + s) * 16 + lane];
          const unsigned o = cvt_pk_bf16(x1 * cs.x - x2 * cs.y, x1 * cs.y + x2 * cs.x);
#pragma unroll
          for (int hd = 0; hd < 8; ++hd) stg<unsigned>(KM + ((size_t)(bl * 8 + hd) * S + s) * 96 + 64 + 2 * lane, o); }
        { const u32x2 wc = ldg<u32x2>(PRW + (size_t)row * RW_COLS + 1536 + 4 * lane); u32x2 wp; wp.x = 0u; wp.y = 0u;
          if (s > 0) wp = ldg<u32x2>(PRW + (size_t)(row - 1) * RW_COLS + 1536 + 4 * lane);
          float c[4] = {bflo(wc.x), bfhi(wc.x), bflo(wc.y), bfhi(wc.y)}; const float p[4] = {bflo(wp.x), bfhi(wp.x), bflo(wp.y), bfhi(wp.y)}; const float m4[4] = {mu4.x, mu4.y, mu4.z, mu4.w};
#pragma unroll
          for (int j = 0; j < 4; ++j) { float v = c[j] + (p[j] - c[j]) * m4[j]; if (lane < 16) v = tanhf(v); else if (lane >= 32) v = sigmoidf_(v); c[j] = v; }
          u32x2 o; o.x = cvt_pk_bf16(c[0], c[1]); o.y = cvt_pk_bf16(c[2], c[3]); stg<u32x2>(LIN + (size_t)row * 256 + 4 * lane, o); }
    }
}

__device__ __forceinline__ void conv_phase(const AP a, int l) {
    const bf16_t* U = (const bf16_t*)(a.ws() + WS_U); bf16_t* ACT = (bf16_t*)(a.ws() + WS_ACT);
    const float* cw = (const float*)a.in(I_CW) + (size_t)l * 3 * 5632; const float* cb = (const float*)a.in(I_CB) + (size_t)l * 5632;
    const int gt = bid_opaque() * NTHREADS + tid_opaque(), ngt = gridDim.x * NTHREADS;
    constexpr int SEG = 16, NSEG = TG / SEG;
#pragma unroll 1
    for (int i = gt; i < NSEG * 352; i += ngt) {
        const int seg = i / 352, c0 = (i - seg * 352) * 8, row0 = seg * SEG, s0 = row0 & 4095;
        float wg[3][8], wv[3][8], bg[8], bv[8];
#pragma unroll
        for (int tp = 0; tp < 3; ++tp) { const f32x4 a0 = ldg<f32x4>(cw + tp * 5632 + c0), a1 = ldg<f32x4>(cw + tp * 5632 + c0 + 4), b0 = ldg<f32x4>(cw + tp * 5632 + DFF + c0), b1 = ldg<f32x4>(cw + tp * 5632 + DFF + c0 + 4);
            wg[tp][0] = a0.x; wg[tp][1] = a0.y; wg[tp][2] = a0.z; wg[tp][3] = a0.w; wg[tp][4] = a1.x; wg[tp][5] = a1.y; wg[tp][6] = a1.z; wg[tp][7] = a1.w;
            wv[tp][0] = b0.x; wv[tp][1] = b0.y; wv[tp][2] = b0.z; wv[tp][3] = b0.w; wv[tp][4] = b1.x; wv[tp][5] = b1.y; wv[tp][6] = b1.z; wv[tp][7] = b1.w; }
        { const f32x4 a0 = ldg<f32x4>(cb + c0), a1 = ldg<f32x4>(cb + c0 + 4), b0 = ldg<f32x4>(cb + DFF + c0), b1 = ldg<f32x4>(cb + DFF + c0 + 4);
            bg[0] = a0.x; bg[1] = a0.y; bg[2] = a0.z; bg[3] = a0.w; bg[4] = a1.x; bg[5] = a1.y; bg[6] = a1.z; bg[7] = a1.w; bv[0] = b0.x; bv[1] = b0.y; bv[2] = b0.z; bv[3] = b0.w; bv[4] = b1.x; bv[5] = b1.y; bv[6] = b1.z; bv[7] = b1.w; }
        float g2[8], v2[8], g1[8], v1[8];
        if (s0 >= 2) { load8(U + (size_t)(row0 - 2) * 5632 + c0, g2); load8(U + (size_t)(row0 - 2) * 5632 + DFF + c0, v2); load8(U + (size_t)(row0 - 1) * 5632 + c0, g1); load8(U + (size_t)(row0 - 1) * 5632 + DFF + c0, v1); }
        else {
#pragma unroll
            for (int j = 0; j < 8; ++j) { g2[j] = 0.f; v2[j] = 0.f; g1[j] = 0.f; v1[j] = 0.f; } }
#pragma unroll 8
        for (int r = 0; r < SEG; ++r) {
            float g0[8], v0[8], o[8]; const bf16_t* up = U + (size_t)(row0 + r) * 5632 + c0; load8_nt(up, g0); load8_nt(up + DFF, v0);
#pragma unroll
            for (int j = 0; j < 8; ++j) { const float cg_ = bg[j] + wg[0][j] * g2[j] + wg[1][j] * g1[j] + wg[2][j] * g0[j], cv_ = bv[j] + wv[0][j] * v2[j] + wv[1][j] * v1[j] + wv[2][j] * v0[j];
                o[j] = cg_ * sigmoidf_(cg_) * cv_; g2[j] = g1[j]; v2[j] = v1[j]; g1[j] = g0[j]; v1[j] = v0[j]; }
            store8(ACT + (size_t)(row0 + r) * DFF + c0, o);
        }
    }
}

#define MFMA32(a, b, c) __builtin_amdgcn_mfma_f32_32x32x16_bf16((a), (b), (c), 0, 0, 0)
__device__ __forceinline__ int pi32(int m) { return (m & ~12) | ((m & 4) << 1) | ((m & 8) >> 1); }
__device__ __forceinline__ float red8(float v) {
    v += __builtin_bit_cast(float, __builtin_amdgcn_update_dpp(0, __builtin_bit_cast(int, v), 0xB1, 0xF, 0xF, true));
    v += __builtin_bit_cast(float, __builtin_amdgcn_update_dpp(0, __builtin_bit_cast(int, v), 0x4E, 0xF, 0xF, true));
    v += __builtin_bit_cast(float, __builtin_amdgcn_update_dpp(0, __builtin_bit_cast(int, v), 0x141, 0xF, 0xF, true));
    return v;
}
__device__ __forceinline__ float fexp2(float x) { return __builtin_amdgcn_exp2f(x); }
__device__ __forceinline__ float xhalf_max(float v) {
    const unsigned u = __builtin_bit_cast(unsigned, v);
    const auto r = __builtin_amdgcn_permlane32_swap(u, u, false, false);
    return fmaxf(__builtin_bit_cast(float, (unsigned)r[0]), __builtin_bit_cast(float, (unsigned)r[1]));
}
__device__ __forceinline__ bf16x8 pack8(const f32x16& p, int s) {
    u32x4 w; w.x = cvt_pk_bf16(p[8 * s + 0], p[8 * s + 1]); w.y = cvt_pk_bf16(p[8 * s + 2], p[8 * s + 3]); w.z = cvt_pk_bf16(p[8 * s + 4], p[8 * s + 5]); w.w = cvt_pk_bf16(p[8 * s + 6], p[8 * s + 7]);
    return __builtin_bit_cast(bf16x8, w);
}
constexpr float NEG_BIG = -1e30f;
constexpr float RESCALE_THR = 8.f;

__device__ __forceinline__ void mla_unit(LAS unsigned char* lds, const AP a, int bl, int hd, int qb) {
    const int tid = tid_opaque(), wave = tid >> 6, lane = tid & 63, n = lane & 31, g = lane >> 5;
    constexpr int KSTR = 104, VSTR = 72, KB_BYTES = 64 * KSTR * 2, VB_BYTES = 64 * VSTR * 2, BUF = KB_BYTES + VB_BYTES;
    const bf16_t* Qp = (const bf16_t*)(a.ws() + WS_QM) + (size_t)(bl * 8 + hd) * S * 96;
    const bf16_t* Kp = (const bf16_t*)(a.ws() + WS_KM) + (size_t)(bl * 8 + hd) * S * 96;
    const bf16_t* Vp = (const bf16_t*)(a.ws() + WS_VTM) + (size_t)(bl * 8 + hd) * 64 * S;
    const int q0 = qb * 512 + wave * 64;
    bf16x8 qa[6], qbf[6];
#pragma unroll
    for (int s = 0; s < 6; ++s) { qa[s] = ldg<bf16x8>(Qp + (size_t)(q0 + n) * 96 + 16 * s + 8 * g); qbf[s] = ldg<bf16x8>(Qp + (size_t)(q0 + 32 + n) * 96 + 16 * s + 8 * g); }
    f32x16 oa[2], ob[2];
#pragma unroll
    for (int i = 0; i < 2; ++i)
#pragma unroll
        for (int r = 0; r < 16; ++r) { oa[i][r] = 0.f; ob[i][r] = 0.f; }
    float ma = NEG_BIG, la = 0.f, mb = NEG_BIG, lb = 0.f;
    const int ntiles = (qb + 1) * 8;
    const int kr_a = tid / 12, kc_a = tid - kr_a * 12, kr_b = (tid + 512) / 12, kc_b = (tid + 512) - kr_b * 12; const bool has_b = tid < 256;
    const int vr_ = tid >> 3, vc_ = tid & 7;
    const unsigned kofs_a = (kr_a * KSTR + kc_a * 8) * 2, kofs_b = (kr_b * KSTR + kc_b * 8) * 2, vofs = KB_BYTES + (vr_ * VSTR + vc_ * 8) * 2;
    u32x4 ka, kb_ = {0u, 0u, 0u, 0u}, vv;
#define MLA_GLOAD(k0) do { ka = ldg<u32x4>(Kp + (size_t)((k0) + kr_a) * 96 + kc_a * 8); if (has_b) kb_ = ldg<u32x4>(Kp + (size_t)((k0) + kr_b) * 96 + kc_b * 8); \
        vv = ldg<u32x4>(Vp + (size_t)vr_ * S + (k0) + vc_ * 8); } while (0)
#define MLA_LSTORE(buf) do { LAS unsigned char* b_ = lds + (buf) * BUF; *(LAS u32x4*)(b_ + kofs_a) = ka; if (has_b) *(LAS u32x4*)(b_ + kofs_b) = kb_; *(LAS u32x4*)(b_ + vofs) = vv; } while (0)
#define MLA_SOFTMAX(S0, BASE, M_, L_, O_, QR) do { \
        if (kbase + 31 > (QR)) { const int rel = (QR) + n - kbase - 8 * g; asm volatile("" ::: "memory"); \
            _Pragma("unroll") for (int r = 0; r < 16; ++r) { if (16 * (r >> 3) + (r & 7) > rel) S0[r] = NEG_BIG; } } \
        float mx = S0[0]; \
        _Pragma("unroll") for (int r = 1; r < 16; ++r) mx = fmaxf(mx, S0[r]); \
        mx = xhalf_max(mx); \
        const float mn = fmaxf(M_, (BASE) + mx); \
        if (__builtin_amdgcn_ballot_w64(mn > M_ + RESCALE_THR) != 0ull) { const float alpha = fexp2(M_ - mn), sh = mn - (BASE); M_ = mn; L_ *= alpha; \
            _Pragma("unroll") for (int i = 0; i < 2; ++i) _Pragma("unroll") for (int r = 0; r < 16; ++r) O_[i][r] *= alpha; \
            _Pragma("unroll") for (int r = 0; r < 16; ++r) S0[r] -= sh; } \
        float ls = 0.f; \
        _Pragma("unroll") for (int r = 0; r < 16; ++r) { S0[r] = fexp2(S0[r]); ls += S0[r]; } \
        L_ += ls; } while (0)
    MLA_GLOAD(0); MLA_LSTORE(0);
    __syncthreads();
    const unsigned krd = (pi32(n) * KSTR + 8 * g) * 2, vrd = KB_BYTES + (n * VSTR + 8 * g) * 2;
#pragma unroll 1
    for (int kt = 0; kt < ntiles; ++kt) {
        if (kt + 1 < ntiles) MLA_GLOAD(kt * 64 + 64);
        {
        const int k0 = kt * 64;
        LAS unsigned char* bb = lds + (kt & 1) * BUF; LAS unsigned char* bv = bb;
#pragma unroll
        for (int kb = 0; kb < 2; ++kb) {
        const int kbase = k0 + kb * 32;
        if (kbase <= q0 + 63) {
            const float basea = (ma > -1e29f) ? ma : 0.f, baseb = (mb > -1e29f) ? mb : 0.f;
            f32x16 a0, b0;
#pragma unroll
            for (int r = 0; r < 16; ++r) { a0[r] = -basea; b0[r] = -baseb; }
#pragma unroll
            for (int s = 0; s < 6; ++s) { const bf16x8 kf = *(const LAS bf16x8*)(bb + krd + (kb * 32 * KSTR + 16 * s) * 2); a0 = MFMA32(kf, qa[s], a0); b0 = MFMA32(kf, qbf[s], b0); }
            MLA_SOFTMAX(a0, basea, ma, la, oa, q0);
            const bf16x8 pa0 = pack8(a0, 0), pa1 = pack8(a0, 1);
            MLA_SOFTMAX(b0, baseb, mb, lb, ob, q0 + 32);
            const bf16x8 pb0 = pack8(b0, 0), pb1 = pack8(b0, 1);
#pragma unroll
            for (int dvb = 0; dvb < 2; ++dvb) {
                const bf16x8 v0 = *(const LAS bf16x8*)(bv + vrd + (dvb * 32 * VSTR + kb * 32) * 2);
                const bf16x8 v1 = *(const LAS bf16x8*)(bv + vrd + (dvb * 32 * VSTR + kb * 32 + 16) * 2);
                oa[dvb] = MFMA32(v0, pa0, oa[dvb]); ob[dvb] = MFMA32(v0, pb0, ob[dvb]); oa[dvb] = MFMA32(v1, pa1, oa[dvb]); ob[dvb] = MFMA32(v1, pb1, ob[dvb]);
            }
        }
        }
        }
        if (kt + 1 < ntiles) MLA_LSTORE((kt + 1) & 1);
        __syncthreads();
    }
#undef MLA_GLOAD
#undef MLA_LSTORE
#undef MLA_SOFTMAX
    la += __shfl_xor(la, 32); lb += __shfl_xor(lb, 32);
    const float ila = 1.f / la, ilb = 1.f / lb;
    bf16_t* op = (bf16_t*)(a.ws() + WS_OML) + (size_t)(bl * S + q0 + n) * 512 + hd * 64 + 4 * g;
#pragma unroll
    for (int dvb = 0; dvb < 2; ++dvb)
#pragma unroll
        for (int c = 0; c < 4; ++c) { u32x2 w; w.x = cvt_pk_bf16(oa[dvb][4 * c] * ila, oa[dvb][4 * c + 1] * ila); w.y = cvt_pk_bf16(oa[dvb][4 * c + 2] * ila, oa[dvb][4 * c + 3] * ila);
            stg<u32x2>(op + dvb * 32 + 8 * c, w);
            u32x2 w2; w2.x = cvt_pk_bf16(ob[dvb][4 * c] * ilb, ob[dvb][4 * c + 1] * ilb); w2.y = cvt_pk_bf16(ob[dvb][4 * c + 2] * ilb, ob[dvb][4 * c + 3] * ilb);
            stg<u32x2>(op + (size_t)32 * 512 + dvb * 32 + 8 * c, w2); }
}

__device__ __forceinline__ int t5_bucket(int n) {
    if (n < 16) return n;
    const float nf = (float)n; int large = 16 + (int)(logf(nf / 16.f) / 2.0794415416798357f * 16.f);
    return large < 31 ? large : 31;
}
__device__ __forceinline__ void diff_unit(LAS unsigned char* lds, const AP a, int l, int grp, int bl, int hd, int qb) {
    const int tid = tid_opaque(), wave = tid >> 6, lane = tid & 63, n = lane & 31, g = lane >> 5, map = wave >> 2, qs = wave & 3;
    constexpr int KSTR = 136, VSTR = 72, KB_BYTES = 64 * KSTR * 2, VB_BYTES = 128 * VSTR * 2, BUF = KB_BYTES + VB_BYTES;
    constexpr int OFF_POS = 3 * BUF, OFF_LUT = OFF_POS + (3 * 64 + 4) * 4;
    constexpr int XSTR = 132;
    const bf16_t* QK = (const bf16_t*)(a.ws() + WS_QKD) + (size_t)bl * S * 1024;
    const bf16_t* Vp = (const bf16_t*)(a.ws() + WS_VTD) + (size_t)(bl * 4 + hd) * 128 * S;
    const int* pos = (const int*)a.in(I_POS) + (size_t)(grp * GB + bl) * S;
    const int q0 = qb * 128 + qs * 32;
    LAS float* lut = (LAS float*)(lds + OFF_LUT); LAS int* posk = (LAS int*)(lds + OFF_POS);
    if (tid < 129) lut[tid] = ((const float*)a.in(I_RELB))[t5_bucket(tid) * 4 + hd] * LOG2E;
    bf16x8 qf[4];
#pragma unroll
    for (int s = 0; s < 4; ++s) qf[s] = ldg<bf16x8>(QK + (size_t)(q0 + n) * 1024 + hd * 128 + map * 64 + 16 * s + 8 * g);
    const int posq = pos[q0 + n];
    int qmin = posq;
#pragma unroll
    for (int of = 1; of < 32; of <<= 1) qmin = min(qmin, __shfl_xor(qmin, of));
    f32x16 o[4];
#pragma unroll
    for (int i = 0; i < 4; ++i)
#pragma unroll
        for (int r = 0; r < 16; ++r) o[i][r] = 0.f;
    float m = NEG_BIG, lsum = 0.f;
    const int ntiles = (qb + 1) * 2;
    const int kr0 = tid >> 4, kc0 = tid & 15, kr1 = kr0 + 32;
    const int vr0 = tid >> 3, vc0 = tid & 7, vr1 = vr0 + 64;
    const unsigned kofs0 = (kr0 * KSTR + kc0 * 8) * 2, kofs1 = (kr1 * KSTR + kc0 * 8) * 2, vofs0 = KB_BYTES + (vr0 * VSTR + vc0 * 8) * 2, vofs1 = KB_BYTES + (vr1 * VSTR + vc0 * 8) * 2;
    u32x4 k0r, k1r, v0r, v1r; int pkr = 0;
#define DF_GLOAD(k0) do { k0r = ldg<u32x4>(QK + (size_t)((k0) + kr0) * 1024 + 512 + hd * 128 + kc0 * 8); k1r = ldg<u32x4>(QK + (size_t)((k0) + kr1) * 1024 + 512 + hd * 128 + kc0 * 8); \
        v0r = ldg<u32x4>(Vp + (size_t)vr0 * S + (k0) + vc0 * 8); v1r = ldg<u32x4>(Vp + (size_t)vr1 * S + (k0) + vc0 * 8); if (tid < 64) pkr = pos[(k0) + tid]; } while (0)
#define DF_LSTORE(buf) do { LAS unsigned char* b_ = lds + (buf) * BUF; *(LAS u32x4*)(b_ + kofs0) = k0r; *(LAS u32x4*)(b_ + kofs1) = k1r; *(LAS u32x4*)(b_ + vofs0) = v0r; *(LAS u32x4*)(b_ + vofs1) = v1r; \
        if (tid < 64) { posk[(buf) * 64 + tid] = pkr; int km_ = pkr; _Pragma("unroll") for (int of = 1; of < 64; of <<= 1) km_ = max(km_, __shfl_xor(km_, of)); if (tid == 0) posk[192 + (buf)] = km_; } } while (0)
    DF_GLOAD(0); DF_LSTORE(0);
    DF_GLOAD(64); DF_LSTORE(1);
    __syncthreads();
    const float lutfar = lut[128];
    const unsigned krd = (pi32(n) * KSTR + map * 64 + 8 * g) * 2, vrd = KB_BYTES + (n * VSTR + 8 * g) * 2;
#define DF_QK(BUFP, ST0, ST1, BASE, ACT1, FAR) do { BASE = (m > -1e29f) ? m : 0.f; const float ci_ = ((FAR) ? lutfar : 0.f) - BASE; \
        _Pragma("unroll") for (int r = 0; r < 16; ++r) { ST0[r] = ci_; ST1[r] = (ACT1) ? ci_ : NEG_BIG; } \
        _Pragma("unroll") for (int s_ = 0; s_ < 4; ++s_) { const bf16x8 kf = *(const LAS bf16x8*)((BUFP) + krd + (16 * s_) * 2); ST0 = MFMA32(kf, qf[s_], ST0); } \
        if (ACT1) { _Pragma("unroll") for (int s_ = 0; s_ < 4; ++s_) { const bf16x8 kf = *(const LAS bf16x8*)((BUFP) + krd + (32 * KSTR + 16 * s_) * 2); ST1 = MFMA32(kf, qf[s_], ST1); } } } while (0)
    f32x16 st0, st1, sn0, sn1; float basec = 0.f, basen = 0.f; bool a1c = (32 <= q0 + 31), a1n = false, farc = (qmin - posk[192] >= 128), farn = false;
#pragma unroll
    for (int r = 0; r < 16; ++r) { sn0[r] = 0.f; sn1[r] = 0.f; }
    DF_QK(lds, st0, st1, basec, a1c, farc);
    int bcur = 0;
#pragma unroll 1
    for (int kt = 0; kt < ntiles; ++kt) {
        const int k0 = kt * 64; const int bnx = (bcur == 2) ? 0 : bcur + 1, bn2 = (bnx == 2) ? 0 : bnx + 1;
        if (kt + 2 < ntiles) DF_GLOAD(k0 + 128);
        LAS unsigned char* bb = lds + bcur * BUF; const LAS int* pk = posk + bcur * 64;
        if (kt + 1 < ntiles && k0 + 64 <= q0 + 31) { farn = (qmin - posk[192 + bnx] >= 128); a1n = (k0 + 96 <= q0 + 31); DF_QK(lds + bnx * BUF, sn0, sn1, basen, a1n, farn); }
        if (k0 <= q0 + 31) {
            if (!farc) { asm volatile("" ::: "memory");
#pragma unroll
                for (int r = 0; r < 16; ++r) { int d0 = posq - pk[16 * (r >> 3) + 8 * g + (r & 7)]; d0 = d0 < 0 ? 0 : (d0 > 128 ? 128 : d0); st0[r] += lut[d0];
                    int d1 = posq - pk[32 + 16 * (r >> 3) + 8 * g + (r & 7)]; d1 = d1 < 0 ? 0 : (d1 > 128 ? 128 : d1); st1[r] += lut[d1]; }
            }
            if (k0 + 63 > q0) { const int rel = q0 + n - k0 - 8 * g; asm volatile("" ::: "memory");
#pragma unroll
                for (int r = 0; r < 16; ++r) { if (16 * (r >> 3) + (r & 7) > rel) st0[r] = NEG_BIG; if (32 + 16 * (r >> 3) + (r & 7) > rel) st1[r] = NEG_BIG; } }
            float mx = fmaxf(st0[0], st1[0]);
#pragma unroll
            for (int r = 1; r < 16; ++r) mx = fmaxf(mx, fmaxf(st0[r], st1[r]));
            mx = xhalf_max(mx);
            const float mn = fmaxf(m, basec + mx);
            if (__builtin_amdgcn_ballot_w64(mn > m + RESCALE_THR) != 0ull) {
                const float alpha = fexp2(m - mn); m = mn; lsum *= alpha;
#pragma unroll
                for (int i = 0; i < 4; ++i)
#pragma unroll
                    for (int r = 0; r < 16; ++r) o[i][r] *= alpha;
            }
            const float sh = m - basec;
            if (__builtin_amdgcn_ballot_w64(sh != 0.f) != 0ull) {
#pragma unroll
                for (int r = 0; r < 16; ++r) { st0[r] -= sh; st1[r] -= sh; }
            }
            float ls = 0.f;
#pragma unroll
            for (int r = 0; r < 16; ++r) { st0[r] = fexp2(st0[r]); st1[r] = fexp2(st1[r]); ls += st0[r] + st1[r]; }
            lsum += ls;
            const bf16x8 p0 = pack8(st0, 0), p1 = pack8(st0, 1), p2 = pack8(st1, 0), p3 = pack8(st1, 1);
#pragma unroll
            for (int dvb = 0; dvb < 4; ++dvb) {
                const bf16x8 v0 = *(const LAS bf16x8*)(bb + vrd + (dvb * 32 * VSTR) * 2);
                const bf16x8 v1 = *(const LAS bf16x8*)(bb + vrd + (dvb * 32 * VSTR + 16) * 2);
                o[dvb] = MFMA32(v0, p0, o[dvb]); o[dvb] = MFMA32(v1, p1, o[dvb]);
                if (a1c) {
                    const bf16x8 v2 = *(const LAS bf16x8*)(bb + vrd + (dvb * 32 * VSTR + 32) * 2);
                    const bf16x8 v3 = *(const LAS bf16x8*)(bb + vrd + (dvb * 32 * VSTR + 48) * 2);
                    o[dvb] = MFMA32(v2, p2, o[dvb]); o[dvb] = MFMA32(v3, p3, o[dvb]); }
            }
        }
        if (kt + 2 < ntiles) DF_LSTORE(bn2);
        __syncthreads();
        st0 = sn0; st1 = sn1; basec = basen; a1c = a1n; farc = farn; bcur = bnx;
    }
#undef DF_QK
#undef DF_GLOAD
#undef DF_LSTORE
    lsum += __shfl_xor(lsum, 32);
    const float* lam = (const float*)a.in(I_LAM) + l * 256;
    const float d01 = wave_sum(lam[lane] * lam[64 + lane]), d23 = wave_sum(lam[128 + lane] * lam[192 + lane]);
    int lo_ = l; asm volatile("" : "+s"(lo_));
    const float lam_init = (lo_ == 0) ? 0.2f : (0.8f - 0.6f * 0.7408182206817179f);
    const float lam_full = __expf(d01) - __expf(d23) + lam_init;
    LAS float* xch = (LAS float*)lds + (qs * 32 + n) * XSTR;
    if (map == 1) { const float sc = lam_full / lsum;
#pragma unroll
        for (int dvb = 0; dvb < 4; ++dvb)
#pragma unroll
            for (int c = 0; c < 4; ++c) { f32x4 w; w.x = o[dvb][4 * c] * sc; w.y = o[dvb][4 * c + 1] * sc; w.z = o[dvb][4 * c + 2] * sc; w.w = o[dvb][4 * c + 3] * sc;
                *(LAS f32x4*)(xch + dvb * 32 + 8 * c + 4 * g) = w; } }
    __syncthreads();
    if (map == 0) { const float il = 1.f / lsum; float ss = 0.f;
#pragma unroll
        for (int dvb = 0; dvb < 4; ++dvb)
#pragma unroll
            for (int c = 0; c < 4; ++c) { const f32x4 w = *(const LAS f32x4*)(xch + dvb * 32 + 8 * c + 4 * g);
                o[dvb][4 * c] = o[dvb][4 * c] * il - w.x; o[dvb][4 * c + 1] = o[dvb][4 * c + 1] * il - w.y; o[dvb][4 * c + 2] = o[dvb][4 * c + 2] * il - w.z; o[dvb][4 * c + 3] = o[dvb][4 * c + 3] * il - w.w;
                ss += o[dvb][4 * c] * o[dvb][4 * c] + o[dvb][4 * c + 1] * o[dvb][4 * c + 1] + o[dvb][4 * c + 2] * o[dvb][4 * c + 2] + o[dvb][4 * c + 3] * o[dvb][4 * c + 3]; }
        ss += __shfl_xor(ss, 32);
        const float rs = rsqrtf(ss * (1.f / 128.f) + 1e-5f) * (1.f - lam_init);
        const float* sub = (const float*)a.in(I_SUBLN) + l * 128;
        bf16_t* op = (bf16_t*)(a.ws() + WS_ODF) + (size_t)(bl * S + q0 + n) * 512 + hd * 128 + 4 * g;
#pragma unroll
        for (int dvb = 0; dvb < 4; ++dvb)
#pragma unroll
            for (int c = 0; c < 4; ++c) { const f32x4 sg = ldg<f32x4>(sub + dvb * 32 + 8 * c + 4 * g);
                u32x2 w; w.x = cvt_pk_bf16(o[dvb][4 * c] * rs * sg.x, o[dvb][4 * c + 1] * rs * sg.y); w.y = cvt_pk_bf16(o[dvb][4 * c + 2] * rs * sg.z, o[dvb][4 * c + 3] * rs * sg.w);
                stg<u32x2>(op + dvb * 32 + 8 * c, w); } }
    __syncthreads();
}

__device__ __forceinline__ float red16(float v) {
    v += __builtin_bit_cast(float, __builtin_amdgcn_update_dpp(0, __builtin_bit_cast(int, v), 0xB1, 0xF, 0xF, true));
    v += __builtin_bit_cast(float, __builtin_amdgcn_update_dpp(0, __builtin_bit_cast(int, v), 0x4E, 0xF, 0xF, true));
    v += __builtin_bit_cast(float, __builtin_amdgcn_update_dpp(0, __builtin_bit_cast(int, v), 0x141, 0xF, 0xF, true));
    v += __builtin_bit_cast(float, __builtin_amdgcn_update_dpp(0, __builtin_bit_cast(int, v), 0x140, 0xF, 0xF, true));
    return v;
}
__device__ __forceinline__ void scan_job(LAS unsigned char* lds, const AP a, int l, int bl, int hd, int rh) {
    const int tid = tid_opaque();
    constexpr int CH = 16, VSZ = CH * 64, BUFSZ = 6 * VSZ, YSTR = 34, YBUF = CH * 16 * YSTR;
    LAS float* vec = (LAS float*)lds; LAS float* Yp = vec + 2 * BUFSZ;
    const bf16_t* PRW = (const bf16_t*)(a.ws() + WS_PRW) + (size_t)bl * S * RW_COLS; const bf16_t* WAG = (const bf16_t*)(a.ws() + WS_WAG) + (size_t)bl * S * 1536;
    float* Yg = (float*)(a.ws() + WS_Y) + (size_t)bl * S * 512 + hd * 64 + rh * 32; float* RKB = (float*)(a.ws() + WS_RKB) + (size_t)bl * S * 8 + hd;
    const bool producer = tid >= 256;
    const int ptid = tid & 255, tt = ptid >> 4, jq = ptid & 15, c0 = hd * 64 + jq * 4;
    float mur[4], muk[4], muv[4], kkp[4], kap[4], rkp[4];
    if (producer) { const float* mu = (const float*)a.in(I_MU) + l * RW_COLS;
#pragma unroll
      for (int j = 0; j < 4; ++j) { mur[j] = ldg<float>(mu + c0 + j); muk[j] = ldg<float>(mu + 512 + c0 + j); muv[j] = ldg<float>(mu + 1024 + c0 + j); kkp[j] = ldg<float>((const float*)a.in(I_KK) + l * 512 + c0 + j);
          kap[j] = ldg<float>((const float*)a.in(I_KA) + l * 512 + c0 + j); rkp[j] = ldg<float>((const float*)a.in(I_RK) + l * 512 + c0 + j); } }
    else {
#pragma unroll
      for (int j = 0; j < 4; ++j) { mur[j] = 0.f; muk[j] = 0.f; muv[j] = 0.f; kkp[j] = 0.f; kap[j] = 0.f; rkp[j] = 0.f; } }
    f32x2 sA0 = {0.f, 0.f}, sA1 = {0.f, 0.f}, sB0 = {0.f, 0.f}, sB1 = {0.f, 0.f};
    const int srow = tt;
#define SCAN_LD4(p_, v_) do { const u32x2 w_ = ldg<u32x2>(p_); v_[0] = bflo(w_.x); v_[1] = bfhi(w_.x); v_[2] = bflo(w_.y); v_[3] = bfhi(w_.y); } while (0)
#define SCAN_PROLOGUE(chn) do { const int t = (chn) * CH + tt; LAS float* bp = vec + ((chn) & 1) * BUFSZ; \
          float r[4], k[4], v[4], pr[4], pk[4], pv[4], e[4], aa[4]; \
          const bf16_t* p = PRW + (size_t)t * RW_COLS + c0; SCAN_LD4(p, r); SCAN_LD4(p + 512, k); SCAN_LD4(p + 1024, v); \
          if (t > 0) { SCAN_LD4(p - RW_COLS, pr); SCAN_LD4(p - RW_COLS + 512, pk); SCAN_LD4(p - RW_COLS + 1024, pv); } \
          else { _Pragma("unroll") for (int j = 0; j < 4; ++j) { pr[j] = 0.f; pk[j] = 0.f; pv[j] = 0.f; } } \
          SCAN_LD4(WAG + (size_t)t * 1536 + c0, e); SCAN_LD4(WAG + (size_t)t * 1536 + 512 + c0, aa); \
          float ss = 0.f, rk = 0.f, kk[4]; \
          _Pragma("unroll") for (int j = 0; j < 4; ++j) { r[j] += (pr[j] - r[j]) * mur[j]; k[j] += (pk[j] - k[j]) * muk[j]; v[j] += (pv[j] - v[j]) * muv[j]; kk[j] = k[j] * kkp[j]; ss += kk[j] * kk[j]; } \
          ss = red16(ss); const float inv = 1.f / fmaxf(sqrtf(ss), 1e-12f); \
          _Pragma("unroll") for (int j = 0; j < 4; ++j) { kk[j] *= inv; k[j] = k[j] * (1.f + (aa[j] - 1.f) * kap[j]); rk += r[j] * k[j] * rkp[j]; e[j] = __expf(-e[j]); aa[j] = kk[j] * aa[j]; } \
          rk = red16(rk); \
          const int o = tt * 64 + jq * 4; \
          *(LAS f32x4*)(bp + o) = (f32x4){r[0], r[1], r[2], r[3]}; *(LAS f32x4*)(bp + VSZ + o) = (f32x4){e[0], e[1], e[2], e[3]}; *(LAS f32x4*)(bp + 2 * VSZ + o) = (f32x4){k[0], k[1], k[2], k[3]}; \
          *(LAS f32x4*)(bp + 3 * VSZ + o) = (f32x4){v[0], v[1], v[2], v[3]}; *(LAS f32x4*)(bp + 4 * VSZ + o) = (f32x4){kk[0], kk[1], kk[2], kk[3]}; *(LAS f32x4*)(bp + 5 * VSZ + o) = (f32x4){aa[0], aa[1], aa[2], aa[3]}; \
          if (rh == 0 && jq == 0) stg<float>(RKB + (size_t)t * 8, rk); } while (0)
#define SCAN_FLUSH(chn) do { const LAS float* yp = Yp + ((chn) & 1) * YBUF + tt * 16 * YSTR + 2 * jq; f32x2 acc_ = {0.f, 0.f}; \
          _Pragma("unroll") for (int q_ = 0; q_ < 16; ++q_) { const f32x2 x_ = *(const LAS f32x2*)(yp + q_ * YSTR); acc_.x += x_.x; acc_.y += x_.y; } \
          stg<f32x2>(Yg + (size_t)((chn) * CH + tt) * 512 + 2 * jq, acc_); } while (0)
    if (producer) SCAN_PROLOGUE(0);
    __syncthreads();
    constexpr int NCH = S / CH;
#pragma unroll 1
    for (int ch = 0; ch < NCH; ++ch) {
        if (producer) {
            if (ch > 0) SCAN_FLUSH(ch - 1);
            if (ch + 1 < NCH) SCAN_PROLOGUE(ch + 1);
        } else {
            __builtin_amdgcn_s_setprio(3);
            const LAS float* bp = vec + (ch & 1) * BUFSZ; LAS float* yl = Yp + (ch & 1) * YBUF + jq * YSTR + 2 * srow;
            const int o0 = jq * 4, vo = 3 * VSZ + rh * 32 + 2 * srow;
            f32x4 rN = *(const LAS f32x4*)(bp + o0), wN = *(const LAS f32x4*)(bp + VSZ + o0), kN = *(const LAS f32x4*)(bp + 2 * VSZ + o0), kkN = *(const LAS f32x4*)(bp + 4 * VSZ + o0), bN = *(const LAS f32x4*)(bp + 5 * VSZ + o0);
            f32x2 vN = *(const LAS f32x2*)(bp + vo);
#pragma unroll 4
            for (int st = 0; st < CH; ++st) {
                const f32x4 w = wN, kk = kkN, b = bN, k = kN, r = rN; const f32x2 v = vN;
                const int on = ((st + 1) & (CH - 1)) * 64;
                rN = *(const LAS f32x4*)(bp + on + o0); wN = *(const LAS f32x4*)(bp + VSZ + on + o0); kN = *(const LAS f32x4*)(bp + 2 * VSZ + on + o0); kkN = *(const LAS f32x4*)(bp + 4 * VSZ + on + o0); bN = *(const LAS f32x4*)(bp + 5 * VSZ + on + o0);
                vN = *(const LAS f32x2*)(bp + on + vo);
                const f32x2 kk0 = {kk.x, kk.y}, kk1 = {kk.z, kk.w}, w0 = {w.x, w.y}, w1 = {w.z, w.w}, b0 = {b.x, b.y}, b1 = {b.z, b.w}, k0 = {k.x, k.y}, k1 = {k.z, k.w}, r0 = {r.x, r.y}, r1 = {r.z, r.w};
                const f32x2 va = {v.x, v.x}, vb = {v.y, v.y};
                const f32x2 pa = sA0 * kk0 + sA1 * kk1, pb = sB0 * kk0 + sB1 * kk1;
                const float saA = -red16(pa.x + pa.y), saB = -red16(pb.x + pb.y);
                const f32x2 sav = {saA, saA}, sbv = {saB, saB};
                sA0 = sA0 * w0 + (sav * b0 + va * k0); sA1 = sA1 * w1 + (sav * b1 + va * k1);
                sB0 = sB0 * w0 + (sbv * b0 + vb * k0); sB1 = sB1 * w1 + (sbv * b1 + vb * k1);
                const f32x2 ya = sA0 * r0 + sA1 * r1, yb = sB0 * r0 + sB1 * r1;
                *(LAS f32x2*)(yl + st * 16 * YSTR) = (f32x2){ya.x + ya.y, yb.x + yb.y};
            }
            __builtin_amdgcn_s_setprio(0);
        }
        __syncthreads();
    }
    if (producer) SCAN_FLUSH(NCH - 1);
#undef SCAN_PROLOGUE
#undef SCAN_FLUSH
#undef SCAN_LD4
    __syncthreads();
}

__device__ __forceinline__ void post_phase(const AP a, int l) {
    const float* Y = (const float*)(a.ws() + WS_Y); const float* RKB = (const float*)(a.ws() + WS_RKB);
    const bf16_t* PRW = (const bf16_t*)(a.ws() + WS_PRW); const bf16_t* WAG = (const bf16_t*)(a.ws() + WS_WAG); bf16_t* ORW = (bf16_t*)(a.ws() + WS_ORW);
    const int gt = bid_opaque() * NTHREADS + tid_opaque(), ngt = gridDim.x * NTHREADS;
    const int c0 = (gt & 63) * 8;
    float mu8[8], lw8[8], lb8[8];
    { const float* mu = (const float*)a.in(I_MU) + l * RW_COLS + 1024 + c0; const float* lnw = (const float*)a.in(I_LNW) + l * 512 + c0; const float* lnb = (const float*)a.in(I_LNB) + l * 512 + c0;
      const f32x4 m0 = ldg<f32x4>(mu), m1 = ldg<f32x4>(mu + 4), w0 = ldg<f32x4>(lnw), w1 = ldg<f32x4>(lnw + 4), b0 = ldg<f32x4>(lnb), b1 = ldg<f32x4>(lnb + 4);
      mu8[0] = m0.x; mu8[1] = m0.y; mu8[2] = m0.z; mu8[3] = m0.w; mu8[4] = m1.x; mu8[5] = m1.y; mu8[6] = m1.z; mu8[7] = m1.w;
      lw8[0] = w0.x; lw8[1] = w0.y; lw8[2] = w0.z; lw8[3] = w0.w; lw8[4] = w1.x; lw8[5] = w1.y; lw8[6] = w1.z; lw8[7] = w1.w;
      lb8[0] = b0.x; lb8[1] = b0.y; lb8[2] = b0.z; lb8[3] = b0.w; lb8[4] = b1.x; lb8[5] = b1.y; lb8[6] = b1.z; lb8[7] = b1.w; }
#pragma unroll 2
    for (int i = gt; i < TG * 64; i += ngt) {
        const int row = i >> 6, s = row & 4095;
        float y[8], v[8], pv[8], gg[8];
        { const f32x4 x0 = ldg<f32x4>(Y + (size_t)row * 512 + c0), x1 = ldg<f32x4>(Y + (size_t)row * 512 + c0 + 4); y[0] = x0.x; y[1] = x0.y; y[2] = x0.z; y[3] = x0.w; y[4] = x1.x; y[5] = x1.y; y[6] = x1.z; y[7] = x1.w; }
        load8(PRW + (size_t)row * RW_COLS + 1024 + c0, v);
        if (s > 0) load8(PRW + (size_t)(row - 1) * RW_COLS + 1024 + c0, pv);
        else {
#pragma unroll
            for (int j = 0; j < 8; ++j) pv[j] = 0.f; }
        load8(WAG + (size_t)row * 1536 + 1024 + c0, gg);
        const float rk = ldg<float>(RKB + (size_t)row * 8 + (c0 >> 6));
        float sm = 0.f;
#pragma unroll
        for (int j = 0; j < 8; ++j) sm += y[j];
        const float mean = red8(sm) * (1.f / 64.f); float sv = 0.f;
#pragma unroll
        for (int j = 0; j < 8; ++j) { y[j] -= mean; sv += y[j] * y[j]; }
        const float rs = rsqrtf(red8(sv) * (1.f / 64.f) + 64e-5f);
#pragma unroll
        for (int j = 0; j < 8; ++j) { const float vm = v[j] + (pv[j] - v[j]) * mu8[j]; y[j] = (y[j] * rs * lw8[j] + lb8[j] + rk * vm) * gg[j]; }
        store8(ORW + (size_t)row * 512 + c0, y);
    }
}

__device__ __forceinline__ void jobs_phase(LAS unsigned char* lds, const AP a, int l, int grp, int rep) {
    unsigned* ctr = (unsigned*)(a.ws() + WS_CTL) + (l * NGRP + grp) * 2 + rep;
    LAS int* jslot = (LAS int*)(lds + 150 * 1024);
    constexpr int NSCAN = GB * 8 * 2, NATT = 8 * 96, NGATE = (TG / 256) * 6, NJOBS = NSCAN + NATT + NGATE;
    for (;;) {
        if (tid_opaque() == 0) *jslot = (int)__hip_atomic_fetch_add(ctr, 1u, __ATOMIC_RELAXED, __HIP_MEMORY_SCOPE_AGENT);
        __syncthreads();
        int j = *jslot;
        __syncthreads();
#ifdef JOBSEL
        if (rep == 1) { if (JOBSEL == 1) { if (j >= NSCAN) break; } else j += NSCAN; }
#endif
        if (j >= NJOBS) break;
        if (j < NSCAN) scan_job(lds, a, l, j >> 4, (j >> 1) & 7, j & 1);
        else if (j >= NSCAN + NATT) {
            const int gq = j - NSCAN - NATT, pn = 15 + 2 * (gq / (TG / 256)), pm = gq % (TG / 256);
            Epi E; E.kind = K_P; E.aux = 0; E.grp = grp; E.pad = 0; E.ws = a.ws(); E.f0 = (const float*)a.in(I_BGATE) + l * GT_COLS; E.f1 = nullptr; E.xi = nullptr; E.xo = nullptr;
            run_gemm_unit(lds, (const bf16_t*)(a.ws() + WS_HB), 1024, (const bf16_t*)(a.ws() + WT_IN), TG, NP, 1024, E, pm, pn, 2);
            __syncthreads(); }
        else { const int q = j - NSCAN, d = q / 96, r = q - d * 96;
            if (r < 32) mla_unit(lds, a, r >> 3, r & 7, 7 - d);
            else { const int rr = r - 32; diff_unit(lds, a, l, grp, (rr & 15) >> 2, rr & 3, 31 - 4 * d - (rr >> 4)); } }
    }
}


constexpr int LDS_BYTES = 151 * 1024;
#ifndef REPEAT_MASK
#define REPEAT_MASK 0
#endif
constexpr int NSLOT = 12 + __builtin_popcount(REPEAT_MASK);
constexpr int NPHASE = 1 + DEPTH * NGRP * NSLOT + 1;
__global__ void __launch_bounds__(NTHREADS, 2) mega(Args a_unused) {
    extern __shared__ __attribute__((aligned(16))) unsigned char lds_raw[];
    LAS unsigned char* lds = (LAS unsigned char*)lds_raw;
    cg::grid_group grid = cg::this_grid();
    { const int tid = threadIdx.x; const unsigned* kp = (const unsigned*)__builtin_amdgcn_kernarg_segment_ptr();
      if (tid < (int)(sizeof(Args) / 4)) ((LAS unsigned*)(lds + ARGS_OFF))[tid] = kp[tid];
      if (tid == 0) { ((LAS unsigned*)(lds + 150 * 1024 + 16))[0] = 0u; ((LAS unsigned*)(lds + 150 * 1024 + 16))[1] = 0u; }
      __syncthreads(); }
    AP a; a.t = (const LAS unsigned long long*)(lds + ARGS_OFF);
    XcdBarrier xbar = xcd_barrier_post((unsigned*)(a.ws() + WS_CTL) + 4096, (volatile LAS unsigned*)(lds + 150 * 1024 + 16));
    const int plo = __builtin_amdgcn_readfirstlane(((const LAS int*)(lds + ARGS_OFF))[70]), phi = __builtin_amdgcn_readfirstlane(((const LAS int*)(lds + ARGS_OFF))[71]);
#pragma unroll 1
    for (int p = plo; p < phi; ++p) {
        unsigned char* ws = a.ws();
        if (p == plo + 1) grid.sync();
        else if (p > plo) xcd_barrier(xbar);
        const int tid = tid_opaque(), lane = tid & 63, wave = __builtin_amdgcn_readfirstlane(tid >> 6);
        const int gw = bid_opaque() * NWAVES + wave, ngw = gridDim.x * NWAVES;
        if (p == 0) { prologue_phase(a); continue; }
        if (p == NPHASE - 1) { rmsnorm_rows_f32(a.out(), (const float*)a.in(I_NFIN), NB * S, gw, ngw, lane); continue; }
                const int idx = p - 1, l = idx / (NGRP * NSLOT), rem = idx % (NGRP * NSLOT), grp = rem / NSLOT, sl = rem % NSLOT;
        int k = 0, rep = 0;
        { int s_ = 0;
          for (int q = 0; q < 12; ++q) { if (s_ == sl) { k = q; rep = 0; break; } ++s_; if ((REPEAT_MASK >> q) & 1) { if (s_ == sl) { k = q; rep = 1; break; } ++s_; } } }
        const float* xin = (l == 0) ? (const float*)a.in(I_X) : (const float*)a.out();
        int ng = 0;
        {
        switch (k) {
        case 0:
            if (grp == 0) wt_convert(a, l, (LAS float*)(lds + wave * 8448), gw, ngw, lane);
            rmsnorm_rows(xin + (size_t)grp * TG * D, (const float*)a.in(I_NMIX) + l * D, (bf16_t*)(ws + WS_HB), TG, gw, ngw, lane);
            break;
        case 2: c1_phase(a, l, grp, gw, ngw, lane); break;
        case 4: jobs_phase(lds, a, l, grp, rep); break;
        case 5: post_phase(a, l); break;
        case 8: rmsnorm_rows(a.out() + (size_t)grp * TG * D, (const float*)a.in(I_NFFN) + l * D, (bf16_t*)(ws + WS_HB), TG, gw, ngw, lane); break;
        case 10: conv_phase(a, l); break;
        case 3: ng = 3; break;
        default: ng = 1; break;
        }
#pragma unroll 1
        for (int gi = 0; gi < ng; ++gi) {
            Epi E; E.kind = K_UP; E.aux = gi; E.grp = grp; E.pad = 0; E.ws = ws; E.f0 = nullptr; E.f1 = nullptr; E.xi = nullptr; E.xo = nullptr;
            size_t aoff = WS_HB, boff = WT_UP, brA = 0, brB = 0; int lda = 1024, N = 5632, K = 1024, nbr = 1;
            switch (k) {
            case 1: E.kind = K_P; boff = WT_IN; N = 3840; break;
            case 3:
                if (gi == 0) { E.kind = K_Q; aoff = WS_CQN; lda = 256; boff = WT_UQ; N = 768; K = 256; }
                else if (gi == 1) { E.kind = K_KV; aoff = WS_CKVN; lda = 128; boff = WT_UKV; N = 1024; K = 128; }
                else { E.kind = K_LORA; E.f0 = (const float*)a.in(I_W0) + l * 512; E.f1 = (const float*)a.in(I_A0) + l * 512; aoff = WS_LIN; lda = 256; boff = WT_LORA; N = 1536; K = 256; }
                break;
            case 6: E.kind = K_BR3; aoff = WS_ORW; lda = 512; boff = WT_BR; N = 1024; K = 512; nbr = 3; brA = 16 * MiB; brB = (size_t)1024 * 512 * 2; break;
            case 7: E.kind = K_WO; E.xi = xin; E.xo = a.out(); boff = WT_O; N = 1024; break;
            case 9: break;
            default: E.kind = K_DN; E.xi = a.out(); E.xo = a.out(); aoff = WS_ACT; lda = DFF; boff = WT_DN; N = 1024; K = DFF; break;
            }
            run_gemm(lds, (const bf16_t*)(ws + aoff), lda, (const bf16_t*)(ws + boff), TG, N, K, E, nbr, brA, brB);
        }
        }
    }
}

#ifndef MK_MULTI
#define MK_MULTI 0
#endif
extern "C" void kernel_launch(void* const* d_in, const int* in_sizes, int n_in, void* d_out, int out_size, void* d_ws, size_t ws_size, hipStream_t stream) {
    static int grid = 0;
    if (grid == 0) {
        if (n_in != 33 || out_size != NB * S * D || ws_size < 512 * MiB) { fprintf(stderr, "kernel_launch: unexpected shapes (n_in %d, out %d, ws %zu)\n", n_in, out_size, ws_size); grid = -1; return; }
        int dev = 0, cus = 0, per_cu = 0;
        hipGetDevice(&dev); hipDeviceGetAttribute(&cus, hipDeviceAttributeMultiprocessorCount, dev);
        if (hipFuncSetAttribute((const void*)mega, hipFuncAttributeMaxDynamicSharedMemorySize, LDS_BYTES) != hipSuccess) { fprintf(stderr, "kernel_launch: hipFuncSetAttribute failed\n"); grid = -1; return; }
        if (hipOccupancyMaxActiveBlocksPerMultiprocessor(&per_cu, (const void*)mega, NTHREADS, LDS_BYTES) != hipSuccess || per_cu < 1) { fprintf(stderr, "kernel_launch: occupancy query says %d\n", per_cu); per_cu = 1; }
        (void)hipGetLastError();
        grid = cus * 1;
    }
    if (grid < 0) return;
    (void)hipMemsetAsync((unsigned char*)d_ws + 16384, 0, 16384, stream);
    Args a{};
    for (int i = 0; i < 33; ++i) a.in[i] = d_in[i];
    a.out = (float*)d_out; a.ws = (unsigned char*)d_ws;
#if MK_MULTI
    for (int p = 0; p < NPHASE; ++p) { a.lo = p; a.hi = p + 1; hipLaunchKernelGGL(mega, dim3(grid), dim3(NTHREADS), LDS_BYTES, stream, a); }
#else
    a.lo = 0; a.hi = NPHASE;
    void* args[] = {&a};
    hipError_t e = hipLaunchCooperativeKernel((const void*)mega, dim3(grid), dim3(NTHREADS), args, LDS_BYTES, stream);
    if (e != hipSuccess) fprintf(stderr, "cooperative launch failed: %s (grid %d)\n", hipGetErrorString(e), grid);
#endif
}
```
